# Optimizing an MI355X kernel written in HIP

```python
import math
import jax, jax.numpy as jnp
from jax import lax
import numpy as np

D_MODEL = 1024
BATCH = 4
SEQ = 8192
DEPTH = 4

GRID_W = 64
CTX_LEN = 256
D_FF = 2816
FFN_RES = 0.5
N_MOD = 9
RMS_EPS = 1e-6

NA_HEADS = 8
NA_HEAD_DIM = 64
NA_WIDTH = NA_HEADS * NA_HEAD_DIM
NA_KH = 8
NA_KW = 16
SC_WIDTH = D_MODEL // 2
AB_IN = 3 * NA_WIDTH + 3 * SC_WIDTH
AB_OUT = NA_WIDTH + SC_WIDTH

HY_WIDTH = D_MODEL
HY_EMB = 33
HY_BANDS = (HY_EMB - 1) // 2
HY_FFN = 64
HY_TARGET = 1e-2
HY_FAST_PCT = 0.3
HY_SLOW_PCT = 1.5

N_EVEN = (DEPTH + 1) // 2
N_ODD = DEPTH // 2

kernel_name = 'hybrid_na_shortconv_hyena_dit'


def rms_norm(x, g):
    xf = x.astype(jnp.float32)
    y = xf * lax.rsqrt(jnp.mean(xf * xf, axis=-1, keepdims=True) + RMS_EPS)
    return (y * g.astype(jnp.float32)).astype(x.dtype)


def modulated_norm(x, g, shift, scale):
    return rms_norm(x, g) * (1 + scale) + shift


def half_step_ffn(x, g_pre, g_post, shift, scale, gate, w_gate, w_up, w_down):
    h = modulated_norm(x, g_pre, shift, scale)
    y = (jax.nn.silu(h @ w_gate) * (h @ w_up)) @ w_down
    return x + FFN_RES * gate * rms_norm(y, g_post)


def short_conv(u, w):
    up = jnp.pad(u, ((0, 0), (1, 1), (0, 0)))
    return up[:, :-2] * w[0] + up[:, 1:-1] * w[1] + up[:, 2:] * w[2]


def window_index(n, k):
    start = jnp.clip(jnp.arange(n) - k // 2, 0, n - k)
    return start[:, None] + jnp.arange(k)[None, :]


def split_heads(t):
    return t.reshape(t.shape[:-1] + (NA_HEADS, NA_HEAD_DIM))


def neighbourhood_attention(q, k, v, k_ctx, v_ctx, rpb):
    b, s, h, dh = q.shape
    rows = s // GRID_W
    kh = min(NA_KH, rows)
    kw = NA_KW
    to_grid = lambda t: t.reshape(b, rows, GRID_W, h, dh)
    qg = to_grid(q) * (dh ** -0.5)
    kg, vg = to_grid(k), to_grid(v)
    row_idx = window_index(rows, kh)
    col_idx = window_index(GRID_W, kw)
    k_band = kg[:, row_idx]
    v_band = vg[:, row_idx]
    sel = (col_idx[:, :, None] == jnp.arange(GRID_W)[None, None, :]).astype(q.dtype)
    s_band = jnp.einsum('brchd,brykhd->bhrcyk', qg, k_band)
    s_win = jnp.einsum('bhrcyk,cwk->bhrcyw', s_band, sel)
    dy = row_idx - jnp.arange(rows)[:, None] + (NA_KH - 1)
    dx = col_idx - jnp.arange(GRID_W)[:, None] + (NA_KW - 1)
    bias = rpb[:, dy[:, None, :, None], dx[None, :, None, :]]
    s_win = s_win + bias[None].astype(s_win.dtype)
    s_ctx = jnp.einsum('brchd,bjhd->bhrcj', qg, k_ctx)
    logits = jnp.concatenate([s_win.reshape(b, h, rows, GRID_W, kh * kw), s_ctx], axis=-1)
    p = jax.nn.softmax(logits.astype(jnp.float32), axis=-1).astype(v.dtype)
    p_win = p[..., :kh * kw].reshape(b, h, rows, GRID_W, kh, kw)
    p_band = jnp.einsum('bhrcyw,cwk->bhrcyk', p_win, sel)
    out = (jnp.einsum('bhrcyk,brykhd->brchd', p_band, v_band)
           + jnp.einsum('bhrcj,bjhd->brchd', p[..., kh * kw:], v_ctx))
    return out.reshape(b, s, h * dh)


def context_attention(q, k, v):
    b, n, h, dh = q.shape
    logits = jnp.einsum('bihd,bjhd->bhij', q * (dh ** -0.5), k)
    p = jax.nn.softmax(logits.astype(jnp.float32), axis=-1).astype(v.dtype)
    return jnp.einsum('bhij,bjhd->bihd', p, v).reshape(b, n, h * dh)


def mixer_ab(h_lat, h_ctx, w_in, rpb, conv_w, w_out, ctx_out):
    cuts = [NA_WIDTH, 2 * NA_WIDTH, 3 * NA_WIDTH, 3 * NA_WIDTH + SC_WIDTH, 3 * NA_WIDTH + 2 * SC_WIDTH]
    q, k, v, gb, gc, xb = jnp.split(h_lat @ w_in, cuts, axis=-1)
    if ctx_out:
        q_c, k_c, v_c, gb_c, gc_c, xb_c = jnp.split(h_ctx @ w_in, cuts, axis=-1)
    else:
        k_c, v_c = jnp.split(h_ctx @ w_in[:, NA_WIDTH:3 * NA_WIDTH], 2, axis=-1)
    k_c, v_c = split_heads(k_c), split_heads(v_c)
    a_lat = neighbourhood_attention(split_heads(q), split_heads(k), split_heads(v), k_c, v_c, rpb)
    b_lat = gb * short_conv(gc * xb, conv_w)
    y_lat = jnp.concatenate([a_lat, b_lat], axis=-1) @ w_out
    if not ctx_out:
        return y_lat, None
    a_ctx = context_attention(split_heads(q_c), k_c, v_c)
    b_ctx = gb_c * short_conv(gc_c * xb_c, conv_w)
    y_ctx = jnp.concatenate([a_ctx, b_ctx], axis=-1) @ w_out
    return y_lat, y_ctx


def hyena_filters(n, w1, b1, w2, b2, w3, b3, w4, freq):
    f32 = jnp.float32
    t = jnp.linspace(0.0, 1.0, n, dtype=f32)[:, None]
    w = 2.0 * math.pi * jnp.arange(n, dtype=f32)[:, None] / n
    bands = jnp.linspace(1e-4, HY_BANDS - 1, HY_BANDS, dtype=f32)[None, :]
    z = jnp.concatenate([t, jnp.cos(bands * w), -jnp.sin(bands * w)], axis=-1)
    fr = freq.astype(f32)
    hdn = jnp.sin(fr * (z @ w1.astype(f32) + b1.astype(f32)))
    hdn = jnp.sin(fr * (hdn @ w2.astype(f32) + b2.astype(f32)))
    hdn = jnp.sin(fr * (hdn @ w3.astype(f32) + b3.astype(f32)))
    filt = (hdn @ w4.astype(f32)).reshape(n, 2, HY_WIDTH)
    max_decay = math.log(HY_TARGET) / HY_FAST_PCT
    min_decay = math.log(HY_TARGET) / HY_SLOW_PCT
    deltas = jnp.linspace(min_decay, max_decay, HY_WIDTH, dtype=f32)
    window = jnp.exp(-t * jnp.abs(deltas)[None, :])
    filt = filt * window[:, None, :]
    return filt[:, 0], filt[:, 1]


def bidirectional_long_conv(u, h_fwd, h_bwd):
    n = u.shape[1]
    k = jnp.concatenate([h_fwd, jnp.zeros((1, HY_WIDTH), jnp.float32), h_bwd[1:][::-1]], axis=0)
    u_f = jnp.fft.rfft(u.astype(jnp.float32), n=2 * n, axis=1)
    k_f = jnp.fft.rfft(k, n=2 * n, axis=0)
    y = jnp.fft.irfft(u_f * k_f[None], n=2 * n, axis=1)[:, :n]
    return y.astype(u.dtype)


def hyena_mixer(h, w_in, short_w, w1, b1, w2, b2, w3, b3, w4, freq, bias, w_out):
    n = h.shape[1]
    x0, x1, v = jnp.split(short_conv(h @ w_in, short_w), 3, axis=-1)
    h_fwd, h_bwd = hyena_filters(n, w1, b1, w2, b2, w3, b3, w4, freq)
    u = v * x1
    return (x0 * (bidirectional_long_conv(u, h_fwd, h_bwd) + u * bias)) @ w_out


def setup_inputs(seed: int = 0) -> dict:
    key = jax.random.key(seed)
    ks = jax.random.split(key, 26)
    f32 = jnp.float32
    nrm = lambda k, shape: jax.random.normal(k, shape, f32)
    lin = lambda k, shape, fan_in: nrm(k, shape) * fan_in ** -0.5
    return {
        'x': nrm(ks[0], (BATCH, SEQ, D_MODEL)),
        'c': nrm(ks[1], (BATCH, D_MODEL)),
        'ctx': nrm(ks[2], (BATCH, CTX_LEN, D_MODEL)),
        'c_ctx': nrm(ks[3], (D_MODEL,)),
        'w_mod': 0.5 * lin(ks[4], (DEPTH, D_MODEL, N_MOD * D_MODEL), D_MODEL),
        'b_mod': 0.02 * nrm(ks[5], (DEPTH, N_MOD * D_MODEL)),
        'norm_g': 1.0 + 0.05 * nrm(ks[6], (DEPTH, 6, D_MODEL)),
        'ffn_w_gate': lin(ks[7], (DEPTH, 2, D_MODEL, D_FF), D_MODEL),
        'ffn_w_up': lin(ks[8], (DEPTH, 2, D_MODEL, D_FF), D_MODEL),
        'ffn_w_down': lin(ks[9], (DEPTH, 2, D_FF, D_MODEL), D_FF),
        'ab_w_in': lin(ks[10], (N_EVEN, D_MODEL, AB_IN), D_MODEL),
        'na_rpb': 0.1 * nrm(ks[11], (N_EVEN, NA_HEADS, 2 * NA_KH - 1, 2 * NA_KW - 1)),
        'sc_conv_w': lin(ks[12], (N_EVEN, 3, SC_WIDTH), 3),
        'ab_w_out': lin(ks[13], (N_EVEN, AB_OUT, D_MODEL), AB_OUT),
        'hy_w_in': lin(ks[14], (N_ODD, D_MODEL, 3 * HY_WIDTH), D_MODEL),
        'hy_short_w': lin(ks[15], (N_ODD, 3, 3 * HY_WIDTH), 3),
        'hy_f_w1': lin(ks[16], (N_ODD, HY_EMB, HY_FFN), HY_EMB),
        'hy_f_b1': 0.02 * nrm(ks[17], (N_ODD, HY_FFN)),
        'hy_f_w2': lin(ks[18], (N_ODD, HY_FFN, HY_FFN), HY_FFN),
        'hy_f_b2': 0.02 * nrm(ks[19], (N_ODD, HY_FFN)),
        'hy_f_w3': lin(ks[20], (N_ODD, HY_FFN, HY_FFN), HY_FFN),
        'hy_f_b3': 0.02 * nrm(ks[21], (N_ODD, HY_FFN)),
        'hy_f_w4': lin(ks[22], (N_ODD, HY_FFN, 2 * HY_WIDTH), HY_FFN),
        'hy_sin_freq': 1.0 + 0.1 * nrm(ks[23], (N_ODD, HY_FFN)),
        'hy_bias': 0.5 * nrm(ks[24], (N_ODD, HY_WIDTH)),
        'hy_w_out': lin(ks[25], (N_ODD, HY_WIDTH, D_MODEL), HY_WIDTH),
    }


def reference(x, c, ctx, c_ctx, w_mod, b_mod, norm_g, ffn_w_gate, ffn_w_up, ffn_w_down,
              ab_w_in, na_rpb, sc_conv_w, ab_w_out,
              hy_w_in, hy_short_w, hy_f_w1, hy_f_b1, hy_f_w2, hy_f_b2, hy_f_w3, hy_f_b3,
              hy_f_w4, hy_sin_freq, hy_bias, hy_w_out):
    b = x.shape[0]
    last_attn = (DEPTH - 1) - (DEPTH - 1) % 2
    for i in range(DEPTH):
        j = i // 2
        g = norm_g[i]
        m_lat = (jax.nn.silu(c) @ w_mod[i] + b_mod[i]).reshape(b, N_MOD, 1, D_MODEL)
        m_ctx = (jax.nn.silu(c_ctx) @ w_mod[i] + b_mod[i]).reshape(N_MOD, D_MODEL)
        keep_ctx = i <= last_attn
        upd_ctx = i < last_attn
        x = half_step_ffn(x, g[0], g[1], m_lat[:, 0], m_lat[:, 1], m_lat[:, 2],
                          ffn_w_gate[i, 0], ffn_w_up[i, 0], ffn_w_down[i, 0])
        h_lat = modulated_norm(x, g[2], m_lat[:, 3], m_lat[:, 4])
        h_ctx = None
        if keep_ctx:
            ctx = half_step_ffn(ctx, g[0], g[1], m_ctx[0], m_ctx[1], m_ctx[2],
                                ffn_w_gate[i, 0], ffn_w_up[i, 0], ffn_w_down[i, 0])
            h_ctx = modulated_norm(ctx, g[2], m_ctx[3], m_ctx[4])
        if i % 2 == 0:
            y_lat, y_ctx = mixer_ab(h_lat, h_ctx, ab_w_in[j], na_rpb[j], sc_conv_w[j], ab_w_out[j], upd_ctx)
        else:
            hy = lambda h: hyena_mixer(h, hy_w_in[j], hy_short_w[j], hy_f_w1[j], hy_f_b1[j], hy_f_w2[j],
                                       hy_f_b2[j], hy_f_w3[j], hy_f_b3[j], hy_f_w4[j], hy_sin_freq[j],
                                       hy_bias[j], hy_w_out[j])
            y_lat = hy(h_lat)
            y_ctx = hy(h_ctx) if upd_ctx else None
        x = x + m_lat[:, 5] * rms_norm(y_lat, g[3])
        x = half_step_ffn(x, g[4], g[5], m_lat[:, 6], m_lat[:, 7], m_lat[:, 8],
                          ffn_w_gate[i, 1], ffn_w_up[i, 1], ffn_w_down[i, 1])
        if upd_ctx:
            ctx = ctx + m_ctx[5] * rms_norm(y_ctx, g[3])
            ctx = half_step_ffn(ctx, g[4], g[5], m_ctx[6], m_ctx[7], m_ctx[8],
                                ffn_w_gate[i, 1], ffn_w_up[i, 1], ffn_w_down[i, 1])
    return x
```

```cpp
#include <hip/hip_runtime.h>
#include <hip/hip_cooperative_groups.h>
#include <cstdio>
#include <cstdint>
namespace cg = cooperative_groups;
#ifndef REP_GEMM
#define REP_GEMM 1
#endif
#ifndef REP_AB
#define REP_AB 1
#endif
#ifndef REP_PREPOST
#define REP_PREPOST 1
#endif
#ifndef REP_PRO
#define REP_PRO 1
#endif
#ifndef REP_R0
#define REP_R0 1
#endif
#ifndef REP_MAX
#define REP_MAX 1
#endif
#ifndef REP_FFT
#define REP_FFT 1
#endif
#ifndef REP_SYNC
#define REP_SYNC 1
#endif
#ifndef REP_RN
#define REP_RN 1
#endif
namespace pg8 {
#define PG8_LAS __attribute__((address_space(3)))
typedef unsigned short bf16_t;
typedef short bf16x8 __attribute__((ext_vector_type(8)));
typedef float f32x4 __attribute__((ext_vector_type(4)));
typedef unsigned u32x4 __attribute__((ext_vector_type(4)));
constexpr int BM = 256, BK = 64, HALF = 128, HTB = HALF * BK * 2  , STAGE_BYTES = 8 * HTB, NXCD = 8, WGM = 8;

__host__ __device__ __forceinline__ int lds_byte(int r, int c) { const int st = (r >> 4) * 2 + (c >> 5), rr = r & 15, cc = c & 31, ob = rr * 64 + cc * 2; return st * 1024 + (ob ^ (((ob >> 9) & 1) << 5)); }
__host__ __device__ __forceinline__ void stage_rc(int b, int& R, int& C) { const int st = b / 1024, sb = b % 1024, swz = sb ^ (((sb >> 9) & 1) << 5); R = (st >> 1) * 16 + swz / 64; C = (st & 1) * 32 + (swz % 64) / 2; }
__host__ __device__ __forceinline__ int perm32(int rho) { const int n = rho >> 4, i = rho & 15; return 8 * (i >> 2) + 4 * n + (i & 3); }

struct Unit { int pm, pn, bn, ko, nt; };
struct Gemm { const bf16_t* A; const bf16_t* Bt; int M, N, K, ld; };

struct StaticOrder {
    int nM, nN, nwg, G, c;
    __host__ __device__ void init(int M, int N, int G_, int c_) { nM = M / BM; nN = N / BM; nwg = nM * nN; G = G_; c = c_; }
    __host__ __device__ bool next(int i, Unit& u) const {
        const long L = (long)i * G + c; if (L >= nwg) return false;
        int wgid = (int)L; { const int q = nwg / NXCD, r = nwg % NXCD, xcd = wgid % NXCD, off = wgid / NXCD; wgid = (xcd < r ? xcd * (q + 1) : r * (q + 1) + (xcd - r) * q) + off; }
        const int nig = WGM * nN, gid = wgid / nig, fm = gid * WGM, gsz = (nM - fm) < WGM ? (nM - fm) : WGM;
        u.pm = fm + ((wgid % nig) % gsz); u.pn = (wgid % nig) / gsz; u.bn = u.pn; u.ko = 0; u.nt = 0; return true;
    }
    __device__ __forceinline__ void a_ready(const Unit&) const {}
    __device__ __forceinline__ void done(const Unit&) const {}
};

__device__ __forceinline__ unsigned cvt_pk_bf16(float lo, float hi) { unsigned r; asm volatile("v_cvt_pk_bf16_f32 %0, %1, %2" : "=v"(r) : "v"(lo), "v"(hi)); return r; }
typedef float f32x2 __attribute__((ext_vector_type(2)));
__device__ __forceinline__ f32x2 gelu_pk(f32x2 v) {
    const f32x2 av = __builtin_elementwise_abs(v), d = av * 0.2316418882f + 1.0f;
    f32x2 t; t.x = __builtin_amdgcn_rcpf(d.x); t.y = __builtin_amdgcn_rcpf(d.y);
    f32x2 q = t * 0.5307027145f + (-0.7265760135f); q = q * t + 0.7107068705f; q = q * t + (-0.142248368f); q = q * t + 0.127414796f; q = q * t;
    const f32x2 s = (v * v) * (-0.72134752044f);
    f32x2 e; e.x = __builtin_amdgcn_exp2f(s.x); e.y = __builtin_amdgcn_exp2f(s.y);
    const f32x2 m = v * (q * e), r = v - m;
    f32x2 o; o.x = v.x < 0.f ? m.x : r.x; o.y = v.y < 0.f ? m.y : r.y; return o;
}

template <int ACT  > struct EpiBf16 {
    static constexpr bool PERM = true, AFTER_DRAIN = false; static_assert(ACT == 0 || ACT == 1, "EpiBf16: ACT is 0 (none) or 1 (gelu_pk)");
    bf16_t* O; int ldc; const float* bias; int split_cols; size_t split_stride; float scale0;
    __device__ __forceinline__ void operator()(const f32x4 (&acc)[2][2][4][2], const Unit& u, int wr, int wc, int fr, int fq) const {
        const int row0 = u.pm * BM + wr * 64 + fr; int colt = u.pn * BM; bf16_t* base = O;
        float sc = 1.f; if (split_cols) { const int t = colt / split_cols; base += (size_t)t * split_stride; colt -= t * split_cols; if (t == 0) sc = scale0; }
        const int col0 = colt + wc * 32 + 8 * fq, bcol0 = u.pn * BM + wc * 32 + 8 * fq;
        f32x4 bv[2][2];
#pragma unroll
        for (int bj = 0; bj < 2; ++bj)
#pragma unroll
            for (int n = 0; n < 2; ++n) bv[bj][n] = bias ? *(const f32x4*)(bias + bcol0 + bj * HALF + 4 * n) : (f32x4){0.f, 0.f, 0.f, 0.f};
#pragma unroll
        for (int ai = 0; ai < 2; ++ai)
#pragma unroll
            for (int m = 0; m < 4; ++m) { bf16_t* rowp = base + (size_t)(row0 + ai * HALF + m * 16) * ldc + col0;
#pragma unroll
                for (int bj = 0; bj < 2; ++bj) { f32x4 v0 = acc[ai][bj][m][0] + bv[bj][0], v1 = acc[ai][bj][m][1] + bv[bj][1];
                    if (ACT == 1) { f32x2 a = gelu_pk((f32x2){v0[0], v0[1]}), b = gelu_pk((f32x2){v0[2], v0[3]}), c = gelu_pk((f32x2){v1[0], v1[1]}), d = gelu_pk((f32x2){v1[2], v1[3]});
                        v0 = (f32x4){a.x, a.y, b.x, b.y}; v1 = (f32x4){c.x, c.y, d.x, d.y}; }
                    v0 = v0 * sc; v1 = v1 * sc; u32x4 w; w.x = cvt_pk_bf16(v0[0], v0[1]); w.y = cvt_pk_bf16(v0[2], v0[3]); w.z = cvt_pk_bf16(v1[0], v1[1]); w.w = cvt_pk_bf16(v1[2], v1[3]);
                    *(u32x4*)(rowp + bj * HALF) = w; } }
    }
};
template <class Epi, class Sched, bool ALIGN_EPI = false, bool SP2 = false>
__device__ __forceinline__ void gemm_phase(PG8_LAS unsigned char* lds, const Gemm g, const Sched& S, const Epi& E) {
    int tid_l = threadIdx.x; asm volatile("" : "+v"(tid_l));
    const int tid = tid_l, wid = __builtin_amdgcn_readfirstlane(tid >> 6), lane = tid & 63, wr = wid >> 2, wc = wid & 3, fr = lane & 15, fq = lane >> 4;
    const int K = g.ld, nt = g.K / BK;
    unsigned voffA[2], voffB[2];
#pragma unroll
    for (int i = 0; i < 2; ++i) { int R, C; stage_rc(tid * 16 + i * 8192, R, C); const int Rb = Epi::PERM ? ((R & ~31) + perm32(R & 31)) : R;
        voffA[i] = (unsigned)(R * K + C) * 2u; voffB[i] = (unsigned)(Rb * K + C) * 2u; }
    const size_t kstep = (size_t)(BK * 2);
    const size_t hstep = (size_t)HALF * K * 2;
    const size_t tstep = 2 * hstep;
    const unsigned ldsw = (unsigned)wid * 1024u;
    const int aoff = lds_byte(wr * 64 + fr, fq * 8), boff = lds_byte(wc * 32 + fr, fq * 8);
#define PG8_SA(b, h) (((b) * 2 + (h)) * HTB)
#define PG8_SB(b, h) ((4 + (b) * 2 + (h)) * HTB)
#define PG8_STAGE(bufoff, gbase, voff) do { _Pragma("unroll") for (int _i = 0; _i < 2; ++_i) \
        __builtin_amdgcn_global_load_lds((const unsigned*)((const char*)(gbase) + (voff)[_i]), (PG8_LAS unsigned*)(lds + (bufoff) + ldsw + _i * 8192), 16, 0, 0); } while (0)
#define PG8_LDA(dst, b, h) do { _Pragma("unroll") for (int m = 0; m < 4; ++m) _Pragma("unroll") for (int k = 0; k < 2; ++k) dst[m][k] = *(const PG8_LAS bf16x8*)(lds + PG8_SA(b, h) + aoff + m * 2048 + k * 1024); } while (0)
#define PG8_LDB(dst, b, h) do { _Pragma("unroll") for (int n = 0; n < 2; ++n) _Pragma("unroll") for (int k = 0; k < 2; ++k) dst[n][k] = *(const PG8_LAS bf16x8*)(lds + PG8_SB(b, h) + boff + n * 2048 + k * 1024); } while (0)
#define PG8_MMA(ai, bj, At, Bt) do { __builtin_amdgcn_s_setprio(1); _Pragma("unroll") for (int m = 0; m < 4; ++m) _Pragma("unroll") for (int n = 0; n < 2; ++n) _Pragma("unroll") for (int k = 0; k < 2; ++k) \
        acc[ai][bj][m][n] = __builtin_amdgcn_mfma_f32_16x16x32_bf16(Bt[n][k], At[m][k], acc[ai][bj][m][n], 0, 0, 0); __builtin_amdgcn_s_setprio(0); } while (0)
#define PG8_WAIT_V(n) asm volatile("s_waitcnt vmcnt(" #n ")" ::: "memory")
#define PG8_WAIT_L(n) asm volatile("s_waitcnt lgkmcnt(" #n ")" ::: "memory")
#define PG8_BAR __builtin_amdgcn_s_barrier()
#define PG8_SCHED __builtin_amdgcn_sched_barrier(0)
    Unit cur, nxt; int ui = 0;
    if (!S.next(0, cur)) return;
    f32x4 acc[2][2][4][2];
#pragma unroll
    for (int a = 0; a < 2; ++a)
#pragma unroll
        for (int b = 0; b < 2; ++b)
#pragma unroll
            for (int m = 0; m < 4; ++m)
#pragma unroll
                for (int n = 0; n < 2; ++n) acc[a][b][m][n] = (f32x4){0.f, 0.f, 0.f, 0.f};
    bf16x8 At[4][2], B0[2][2], B1[2][2];
    const char* cA = (const char*)g.A + (size_t)cur.pm * tstep + (size_t)cur.ko * 2; const char* cB = (const char*)g.Bt + (size_t)cur.bn * tstep + (size_t)cur.ko * 2;
    S.a_ready(cur);
    if constexpr (SP2) {
        PG8_STAGE(PG8_SB(0, 0), cB, voffB); PG8_STAGE(PG8_SB(0, 1), cB + hstep, voffB); PG8_STAGE(PG8_SA(0, 0), cA, voffA); PG8_STAGE(PG8_SA(0, 1), cA + hstep, voffA);
        if (wr == 1) PG8_BAR;
        PG8_WAIT_V(2); PG8_BAR;
        PG8_STAGE(PG8_SB(1, 0), cB + kstep, voffB); PG8_STAGE(PG8_SA(1, 0), cA + kstep, voffA); PG8_STAGE(PG8_SB(1, 1), cB + hstep + kstep, voffB);
        PG8_WAIT_V(6); PG8_BAR;
    } else {
        PG8_STAGE(PG8_SB(0, 0), cB, voffB); PG8_STAGE(PG8_SA(0, 0), cA, voffA); PG8_STAGE(PG8_SB(0, 1), cB + hstep, voffB); PG8_STAGE(PG8_SA(0, 1), cA + hstep, voffA);
        if (wr == 1) PG8_BAR;
        PG8_WAIT_V(4); PG8_BAR;
        PG8_STAGE(PG8_SB(1, 0), cB + kstep, voffB); PG8_STAGE(PG8_SA(1, 0), cA + kstep, voffA); PG8_STAGE(PG8_SB(1, 1), cB + hstep + kstep, voffB);
        PG8_WAIT_V(6); PG8_BAR;
    }
    for (;;) {
        const bool has_next = S.next(ui + 1, nxt);
        const char* nA = has_next ? (const char*)g.A + (size_t)nxt.pm * tstep + (size_t)nxt.ko * 2 : cA; const char* nB = has_next ? (const char*)g.Bt + (size_t)nxt.bn * tstep + (size_t)nxt.ko * 2 : cB;
        const int ntc = cur.nt ? cur.nt : nt;
        for (int t = 0; t < ntc; t += 2) {
            const bool last = (t == ntc - 2);
            const char* a1 = cA + (size_t)(t + 1) * kstep;
            const char* a2 = last ? nA : cA + (size_t)(t + 2) * kstep; const char* b2 = last ? nB : cB + (size_t)(t + 2) * kstep;
            const char* a3 = a2 + kstep; const char* b3 = b2 + kstep;
            if (last && has_next) S.a_ready(nxt);
            if constexpr (SP2) {
            PG8_LDB(B0, 0, 0); PG8_LDB(B1, 0, 1); PG8_SCHED; PG8_LDA(At, 0, 0); PG8_STAGE(PG8_SA(1, 1), a1 + hstep, voffA);
            PG8_WAIT_V(8); PG8_WAIT_L(0); PG8_BAR; PG8_MMA(0, 0, At, B0); PG8_MMA(0, 1, At, B1); PG8_BAR; PG8_SCHED;
            PG8_LDA(At, 0, 1); PG8_STAGE(PG8_SB(0, 0), b2, voffB); PG8_STAGE(PG8_SB(0, 1), b2 + hstep, voffB); PG8_STAGE(PG8_SA(0, 0), a2, voffA);
            PG8_WAIT_V(8); PG8_WAIT_L(0); PG8_BAR; PG8_MMA(1, 0, At, B0); PG8_MMA(1, 1, At, B1); PG8_BAR; PG8_SCHED;
            PG8_LDB(B0, 1, 0); PG8_LDB(B1, 1, 1); PG8_SCHED; PG8_LDA(At, 1, 0); PG8_STAGE(PG8_SA(0, 1), a2 + hstep, voffA);
            PG8_WAIT_V(8); PG8_WAIT_L(0); PG8_BAR; PG8_MMA(0, 0, At, B0); PG8_MMA(0, 1, At, B1); PG8_BAR; PG8_SCHED;
            PG8_LDA(At, 1, 1); PG8_STAGE(PG8_SB(1, 0), b3, voffB); PG8_STAGE(PG8_SB(1, 1), b3 + hstep, voffB); PG8_STAGE(PG8_SA(1, 0), a3, voffA);
            PG8_WAIT_V(8); PG8_WAIT_L(0); PG8_BAR; PG8_MMA(1, 0, At, B0); PG8_MMA(1, 1, At, B1); PG8_BAR; PG8_SCHED;
            } else {
            PG8_LDB(B0, 0, 0); PG8_SCHED; PG8_LDA(At, 0, 0); PG8_STAGE(PG8_SA(1, 1), a1 + hstep, voffA);
            PG8_WAIT_L(8); PG8_BAR; PG8_WAIT_L(0); PG8_MMA(0, 0, At, B0); PG8_BAR; PG8_SCHED;
            PG8_LDB(B1, 0, 1); PG8_STAGE(PG8_SB(0, 0), b2, voffB);
            PG8_BAR; PG8_WAIT_L(0); PG8_MMA(0, 1, At, B1); PG8_BAR;
            PG8_LDA(At, 0, 1); PG8_STAGE(PG8_SA(0, 0), a2, voffA);
            PG8_BAR; PG8_WAIT_L(0); PG8_MMA(1, 0, At, B0); PG8_BAR; PG8_SCHED;
            PG8_STAGE(PG8_SB(0, 1), b2 + hstep, voffB);
            PG8_WAIT_V(6); PG8_BAR; PG8_MMA(1, 1, At, B1); PG8_BAR;
            PG8_LDB(B0, 1, 0); PG8_SCHED; PG8_LDA(At, 1, 0); PG8_STAGE(PG8_SA(0, 1), a2 + hstep, voffA);
            PG8_WAIT_L(8); PG8_BAR; PG8_WAIT_L(0); PG8_MMA(0, 0, At, B0); PG8_BAR; PG8_SCHED;
            PG8_LDB(B1, 1, 1); PG8_STAGE(PG8_SB(1, 0), b3, voffB);
            PG8_BAR; PG8_WAIT_L(0); PG8_MMA(0, 1, At, B1); PG8_BAR;
            PG8_LDA(At, 1, 1); PG8_STAGE(PG8_SA(1, 0), a3, voffA);
            PG8_BAR; PG8_WAIT_L(0); PG8_MMA(1, 0, At, B0); PG8_BAR; PG8_SCHED;
            PG8_STAGE(PG8_SB(1, 1), b3 + hstep, voffB);
            PG8_WAIT_V(6); PG8_BAR; PG8_MMA(1, 1, At, B1); PG8_BAR;
            }
        }
        if constexpr (ALIGN_EPI) { if (wr == 0) PG8_BAR; }
        if constexpr (!Epi::AFTER_DRAIN) { E(acc, cur, wr, wc, fr, fq); S.done(cur); }
        if (!has_next) break;
#pragma unroll
        for (int a = 0; a < 2; ++a)
#pragma unroll
            for (int b = 0; b < 2; ++b)
#pragma unroll
                for (int m = 0; m < 4; ++m)
#pragma unroll
                    for (int n = 0; n < 2; ++n) acc[a][b][m][n] = (f32x4){0.f, 0.f, 0.f, 0.f};
        cur = nxt; cA = nA; cB = nB; ++ui;
        if constexpr (ALIGN_EPI) { if (wr == 1) PG8_BAR; }
    }
    PG8_WAIT_V(0);
    if constexpr (!ALIGN_EPI) { if (wr == 0) PG8_BAR; }
    PG8_BAR;
    if constexpr (Epi::AFTER_DRAIN) { E.fused(acc, cur, wr, wc, fr, fq, lds, wid, lane); S.done(cur); }
#undef PG8_SA
#undef PG8_SB
#undef PG8_STAGE
#undef PG8_LDA
#undef PG8_LDB
#undef PG8_MMA
#undef PG8_WAIT_V
#undef PG8_WAIT_L
#undef PG8_BAR
#undef PG8_SCHED
}
}

#define LAS __attribute__((address_space(3)))
typedef unsigned short bf16;
typedef unsigned u32x4 __attribute__((ext_vector_type(4)));
typedef unsigned u32x2 __attribute__((ext_vector_type(2)));
typedef float f32x4 __attribute__((ext_vector_type(4)));
typedef short bf16x8 __attribute__((ext_vector_type(8)));

constexpr int D = 1024, NB = 4, SEQ = 8192, CTXL = 256, DFF = 2816, NMODW = 9 * 1024;
constexpr int MLAT = NB * SEQ, MCTX = NB * CTXL, MTOT = MLAT + MCTX, ZW = 3072;
constexpr int NTHREADS = 512, NWAVES = 8;
constexpr float RMS_EPS = 1e-6f;
constexpr int FFTN = 16384;
constexpr int LDS_BYTES = 140288;

constexpr size_t MiB = 1u << 20;
constexpr size_t WS_BAR = 50 * MiB, BAR_BYTES = 16384;
constexpr size_t WS_XC = 0, WS_MOD = 4 * MiB, WS_TW = 5 * MiB, WS_FTC = 6 * MiB, WS_W = 8 * MiB;
constexpr size_t W_GU = (size_t)2 * DFF * D * 2, W_DN = (size_t)D * DFF * 2, W_IN = (size_t)ZW * D * 2, W_OUT = (size_t)D * D * 2;
constexpr size_t WO_GU1 = 0, WO_D1 = W_GU, WO_IN = WO_D1 + W_DN, WO_OUT = WO_IN + W_IN, WO_GU2 = WO_OUT + W_OUT, WO_D2 = WO_GU2 + W_GU, W_TOTAL = WO_D2 + W_DN;
constexpr size_t WS_H = 52 * MiB, WS_Y = 118 * MiB, WS_Z = 184 * MiB, WS_VT = 382 * MiB, WS_XB = 415 * MiB, WS_KFS = 543 * MiB, WS_END = 575 * MiB;
static_assert(WS_W + W_TOTAL <= WS_BAR && WS_BAR + BAR_BYTES <= WS_H, "weights region");
static_assert(WS_H + (size_t)MTOT * D * 2 <= WS_Y && WS_Y + (size_t)MTOT * D * 2 <= WS_Z && WS_Z + (size_t)MTOT * ZW * 2 <= WS_VT, "ws map");
static_assert(WS_VT + (size_t)512 * MTOT * 2 <= WS_XB && WS_XB + (size_t)MTOT * D * 2 <= WS_KFS && WS_KFS + (size_t)256 * FFTN * 8 <= WS_END && (size_t)2 * 2 * 1024 * 8192 * 4 <= (size_t)MLAT * D * 4, "ws map 2");

struct Args { const float* in[26]; float* out; unsigned char* ws; };
#define CAS __attribute__((address_space(4)))
typedef CAS const unsigned char* kptr_t;
__device__ __forceinline__ kptr_t karg_base() { kptr_t kp = (kptr_t)__builtin_amdgcn_kernarg_segment_ptr(); asm volatile("" : "+s"(kp)); return kp; }
#define KIN(i) (*(const float* CAS const*)(karg_base() + 8 * (i)))
#define KOUT() (*(float* CAS const*)(karg_base() + 208))
#define KWS() (*(unsigned char* CAS const*)(karg_base() + 216))

__device__ __forceinline__ float bf_lo(unsigned v) { return __uint_as_float(v << 16); }
__device__ __forceinline__ float bf_hi(unsigned v) { return __uint_as_float(v & 0xffff0000u); }
__device__ __forceinline__ float bf1(unsigned short v) { return __uint_as_float((unsigned)v << 16); }
__device__ __forceinline__ unsigned pk2(float lo, float hi) { return pg8::cvt_pk_bf16(lo, hi); }
__device__ __forceinline__ unsigned short f2bf(float f) { return (unsigned short)(pg8::cvt_pk_bf16(f, 0.f) & 0xffffu); }
#define UNPACK8(v, f) do { f[0] = bf_lo(v.x); f[1] = bf_hi(v.x); f[2] = bf_lo(v.y); f[3] = bf_hi(v.y); f[4] = bf_lo(v.z); f[5] = bf_hi(v.z); f[6] = bf_lo(v.w); f[7] = bf_hi(v.w); } while (0)
__device__ __forceinline__ float lane_xor_f(float v, int mask, int lane) { return __builtin_bit_cast(float, __builtin_amdgcn_ds_bpermute((lane ^ mask) << 2, __builtin_bit_cast(int, v))); }
__device__ __forceinline__ float lane_get_f(float v, int src) { return __builtin_bit_cast(float, __builtin_amdgcn_ds_bpermute(src << 2, __builtin_bit_cast(int, v))); }
__device__ __forceinline__ float wave_sum(float v, int lane) {
#pragma unroll
    for (int o = 1; o < 64; o <<= 1) v += lane_xor_f(v, o, lane);
    return v;
}
#define LDS_WAIT() asm volatile("s_waitcnt lgkmcnt(0)" ::: "memory")
#define XB_TMO      128
#define XB_XCNT(j)  (256  + 64 * (j))
#define XB_XSUB(j)  (1280 + 64 * (j))
#define XB_XGEN(j)  (2304 + 64 * (j))
#define XB_TOP      3328
#define XB_TOPGEN   3392
#define XCD_BAR_WORDS 3456
static_assert(XCD_BAR_WORDS * 4 <= BAR_BYTES, "barrier words");
#define XB_SPIN_CAP (1u << 18)

__device__ __forceinline__ unsigned xb_ld(unsigned* p)              { return __hip_atomic_load(p, __ATOMIC_RELAXED, __HIP_MEMORY_SCOPE_AGENT); }
__device__ __forceinline__ unsigned xb_add(unsigned* p, unsigned v) { return __hip_atomic_fetch_add(p, v, __ATOMIC_RELAXED, __HIP_MEMORY_SCOPE_AGENT); }
__device__ __forceinline__ unsigned xb_xcc_id() { return (unsigned)__builtin_amdgcn_s_getreg((3 << 11) | 20) & 0xFu; }
#define XB_SPIN(cond, bar) do { unsigned _sp = 0; while (cond) { __builtin_amdgcn_s_sleep(1); \
    if ((++_sp & 255u) == 0u) { if (xb_ld(&(bar)[XB_TMO])) break; if (_sp > XB_SPIN_CAP) { atomicAdd(&(bar)[XB_TMO], 1u); break; } } } } while (0)

struct XcdBarrier {
    unsigned* bar; unsigned x;
    volatile LAS unsigned* st;
};

__device__ __forceinline__ XcdBarrier xcd_barrier_post(unsigned* bar, volatile LAS unsigned* st) {
    XcdBarrier b; b.bar = bar; b.x = xb_xcc_id(); b.st = st;
    if (threadIdx.x == 0) (void)xb_add(&bar[XB_XCNT(b.x)], 1u);
    return b;
}
__device__ __forceinline__ void xcd_barrier_complete(unsigned* bar, unsigned x, unsigned& nloc, unsigned& nx) {
    const unsigned G = gridDim.x * gridDim.y * gridDim.z;
    unsigned sum, cnt, mine, sp = 0u;
    for (;;) {
        sum = 0u; cnt = 0u; mine = 0u;
#pragma unroll
        for (unsigned j = 0; j < 16; ++j) { const unsigned c = xb_ld(&bar[XB_XCNT(j)]); sum += c; cnt += (c > 0u) ? 1u : 0u; mine = (j == x) ? c : mine; }
        if (sum == G) break;
        __builtin_amdgcn_s_sleep(1);
        if ((++sp & 255u) == 0u) { if (xb_ld(&bar[XB_TMO])) break; if (sp > XB_SPIN_CAP) { atomicAdd(&bar[XB_TMO], 1u); break; } }
    }
    nloc = mine > 0u ? mine : 1u; nx = cnt > 0u ? cnt : 1u;
}

__device__ __forceinline__ void xcd_barrier(const XcdBarrier& b) {
    asm volatile("s_waitcnt vmcnt(0)" ::: "memory");
    __syncthreads();
    if (threadIdx.x == 0) {
        unsigned* bar = b.bar;
        __builtin_amdgcn_s_waitcnt(0);
        unsigned nloc = b.st[0], nx = b.st[1];
        if (nloc == 0u) { xcd_barrier_complete(bar, b.x, nloc, nx); b.st[0] = nloc; b.st[1] = nx; }
        const unsigned old = xb_add(&bar[XB_XSUB(b.x)], 1u);
        const unsigned gen = old / nloc;
        if (old + 1u == (gen + 1u) * nloc) {
            __builtin_amdgcn_fence(__ATOMIC_RELEASE, "agent");
            asm volatile("s_waitcnt vmcnt(0)" ::: "memory");
            const unsigned og = xb_add(&bar[XB_TOP], 1u);
            const unsigned tg = og / nx;
            if (og + 1u == (tg + 1u) * nx) xb_add(&bar[XB_TOPGEN], 1u);
            else XB_SPIN(xb_ld(&bar[XB_TOPGEN]) == tg, bar);
            __builtin_amdgcn_fence(__ATOMIC_ACQUIRE, "agent");
            xb_add(&bar[XB_XGEN(b.x)], 1u);
            asm volatile("s_waitcnt vmcnt(0)" ::: "memory");
        } else {
            XB_SPIN(xb_ld(&bar[XB_XGEN(b.x)]) == gen, bar);
            __builtin_amdgcn_fence(__ATOMIC_ACQUIRE, "agent");
            asm volatile("s_waitcnt vmcnt(0)" ::: "memory");
        }
    }
    __syncthreads();
}


struct EpiSwiglu {
    static constexpr bool PERM = true, AFTER_DRAIN = false;
    bf16* O; int ldc;
    __device__ __forceinline__ void operator()(const pg8::f32x4 (&acc)[2][2][4][2], const pg8::Unit& u, int wr, int wc, int fr, int fq) const {
        const int row0 = u.pm * 256 + wr * 64 + fr, col0 = u.pn * 128 + wc * 32 + 8 * fq;
#pragma unroll
        for (int ai = 0; ai < 2; ++ai)
#pragma unroll
            for (int m = 0; m < 4; ++m) {
                bf16* rowp = O + (size_t)(row0 + ai * 128 + m * 16) * ldc + col0;
                float v[8];
#pragma unroll
                for (int n = 0; n < 2; ++n)
#pragma unroll
                    for (int e = 0; e < 4; ++e) { const float g = acc[ai][0][m][n][e], up = acc[ai][1][m][n][e]; v[n * 4 + e] = g * __builtin_amdgcn_rcpf(1.f + __builtin_amdgcn_exp2f(g * -1.4426950408889634f)) * up; }
                u32x4 w; w.x = pk2(v[0], v[1]); w.y = pk2(v[2], v[3]); w.z = pk2(v[4], v[5]); w.w = pk2(v[6], v[7]);
                *(u32x4*)rowp = w;
            }
    }
};

struct UniOrder {
    pg8::StaticOrder so; int KS; int nvt;
    __device__ __forceinline__ bool next(int i, pg8::Unit& u) const {
        if (so.next(i, u)) { if (nvt && u.pn >= 4) { u.pn += 2; u.bn = u.pn; } return true; }
        const int v = i * so.G + so.c - so.nwg;
        if (nvt) {
            if (v >= nvt) return false;
            const int tt = v >> 1, vt = v & 1; u.pm = vt - 51; u.bn = 55 + tt; u.pn = 1000 + tt; u.ko = 0; u.nt = 0; return true;
        }
        if (KS) {
            if (v >= 16 * KS) return false;
            const int ks = v % KS, tile = v / KS; u.pm = 128 + (tile >> 2); u.bn = tile & 3; u.pn = 1000 + ks * 4 + (tile & 3); u.ko = ks * 256; u.nt = 4; return true;
        }
        return false;
    }
    __device__ __forceinline__ void a_ready(const pg8::Unit&) const {}
    __device__ __forceinline__ void done(const pg8::Unit&) const {}
};
struct EpiZV {
    static constexpr bool PERM = true, AFTER_DRAIN = false;
    pg8::EpiBf16<0> ez, ev; int pm_adj;
    __device__ __forceinline__ void operator()(const pg8::f32x4 (&acc)[2][2][4][2], const pg8::Unit& u, int wr, int wc, int fr, int fq) const {
        if (u.pn >= 1000) { pg8::Unit u2 = u; u2.pm = u.pm + pm_adj; u2.pn = u.pn - 1000; ev(acc, u2, wr, wc, fr, fq); } else ez(acc, u, wr, wc, fr, fq);
    }
};
template <class Epi>
__device__ __forceinline__ void run_gemm(LAS unsigned char* lds, const bf16* A, const bf16* Bt, int M, int N, int K, int G, const Epi& E) {
    pg8::Gemm g{A, Bt, M, N, K, K}; UniOrder S; S.so.init(M, N, G, (int)blockIdx.x); S.KS = 0; S.nvt = 0;
    pg8::gemm_phase<Epi, UniOrder, true, true>(lds, g, S, E);
}

constexpr int TR_SCR_BYTES = 64 * 65 * 4;
__device__ __forceinline__ void transpose_item(const float* __restrict__ W, int K, int N, bf16* WT, int il, LAS float* scr, int item, int lane) {
    const int nblk = N / 64, kb = item / nblk, nb = item % nblk, k0 = 64 * kb, n0 = 64 * nb;
    f32x4 v[16];
#pragma unroll
    for (int i = 0; i < 16; ++i) v[i] = *(const f32x4*)(W + (size_t)(k0 + 4 * i + (lane >> 4)) * N + n0 + (lane & 15) * 4);
#pragma unroll
    for (int i = 0; i < 16; ++i) { LAS float* d = scr + (4 * i + (lane >> 4)) * 65 + (lane & 15) * 4; d[0] = v[i].x; d[1] = v[i].y; d[2] = v[i].z; d[3] = v[i].w; }
    LDS_WAIT(); asm volatile("" ::: "memory");
    const int rbase = il ? ((n0 >> 7) * 256 + (n0 & 127) + (il == 2 ? 128 : 0)) : n0;
    const int c = lane & 7;
#pragma unroll
    for (int j = 0; j < 8; ++j) { const int n = (lane >> 3) + 8 * j; const LAS float* s = scr + (8 * c) * 65 + n;
        u32x4 o; o.x = pk2(s[0 * 65], s[1 * 65]); o.y = pk2(s[2 * 65], s[3 * 65]); o.z = pk2(s[4 * 65], s[5 * 65]); o.w = pk2(s[6 * 65], s[7 * 65]);
        *(u32x4*)(WT + (size_t)(rbase + n) * K + k0 + 8 * c) = o; }
    LDS_WAIT(); asm volatile("" ::: "memory");
}
__device__ __forceinline__ void convert_layer(const Args& a, int l, LAS unsigned char* lds, int G, int wave, int lane, int skip_blocks = 0) {
    LAS float* scr = (LAS float*)(lds + wave * TR_SCR_BYTES);
    const int j = l >> 1; const bool even = !(l & 1);
    unsigned char* wb = KWS() + WS_W;
    const float* g1 = KIN(7) + (size_t)(l * 2) * D * DFF; const float* u1 = KIN(8) + (size_t)(l * 2) * D * DFF; const float* d1 = KIN(9) + (size_t)(l * 2) * DFF * D;
    const float* g2 = g1 + (size_t)D * DFF; const float* u2 = u1 + (size_t)D * DFF; const float* d2 = d1 + (size_t)DFF * D;
    const float* win = even ? KIN(10) + (size_t)j * D * ZW : KIN(14) + (size_t)j * D * ZW;
    const float* wout = even ? KIN(13) + (size_t)j * D * D : KIN(25) + (size_t)j * D * D;
    constexpr int I_G = (D / 64) * (DFF / 64), I_D = (DFF / 64) * (D / 64), I_IN = (D / 64) * (ZW / 64), I_OUT = (D / 64) * (D / 64);
    constexpr int NITEMS = 4 * I_G + 2 * I_D + I_IN + I_OUT;
    if ((int)blockIdx.x < skip_blocks) return;
    const int gw = ((int)blockIdx.x - skip_blocks) * NWAVES + wave, NGW = (G - skip_blocks) * NWAVES;
    for (int it = gw; it < NITEMS; it += NGW) {
        int r = it;
        if (r < I_G) { transpose_item(g1, D, DFF, (bf16*)(wb + WO_GU1), 1, scr, r, lane); continue; } r -= I_G;
        if (r < I_G) { transpose_item(u1, D, DFF, (bf16*)(wb + WO_GU1), 2, scr, r, lane); continue; } r -= I_G;
        if (r < I_D) { transpose_item(d1, DFF, D, (bf16*)(wb + WO_D1), 0, scr, r, lane); continue; } r -= I_D;
        if (r < I_IN) { transpose_item(win, D, ZW, (bf16*)(wb + WO_IN), 0, scr, r, lane); continue; } r -= I_IN;
        if (r < I_OUT) { transpose_item(wout, D, D, (bf16*)(wb + WO_OUT), 0, scr, r, lane); continue; } r -= I_OUT;
        if (r < I_G) { transpose_item(g2, D, DFF, (bf16*)(wb + WO_GU2), 1, scr, r, lane); continue; } r -= I_G;
        if (r < I_G) { transpose_item(u2, D, DFF, (bf16*)(wb + WO_GU2), 2, scr, r, lane); continue; } r -= I_G;
        transpose_item(d2, DFF, D, (bf16*)(wb + WO_D2), 0, scr, r, lane);
    }
}

__device__ __forceinline__ void mod_phase(const Args& a, LAS unsigned char* lds, int G, int tid, int wave, int lane) {
    LAS float* sS = (LAS float*)lds;
    LAS float* red = (LAS float*)(lds + 20480);
    float* MOD = (float*)(KWS() + WS_MOD);
    for (int idx = tid; idx < 5 * 1024; idx += NTHREADS) { const int r = idx >> 10, k = idx & 1023; const float v = r < 4 ? KIN(1)[r * 1024 + k] : KIN(3)[k]; sS[idx] = v / (1.f + expf(-v)); }
    __syncthreads();
    for (int item = blockIdx.x; item < 4 * 144; item += G) {
        const int l = item / 144, ch = item % 144, n = ch * 64 + lane;
        const float* wp = KIN(4) + (size_t)l * D * NMODW + (size_t)(wave * 128) * NMODW + n;
        float acc[5] = {0.f, 0.f, 0.f, 0.f, 0.f};
#pragma unroll 8
        for (int kk = 0; kk < 128; ++kk) { const float wv = wp[(size_t)kk * NMODW];
#pragma unroll
            for (int r = 0; r < 5; ++r) acc[r] += sS[r * 1024 + wave * 128 + kk] * wv; }
#pragma unroll
        for (int r = 0; r < 5; ++r) red[(wave * 5 + r) * 64 + lane] = acc[r];
        __syncthreads();
        if (tid < 320) { const int r = tid >> 6, nn = tid & 63; float s = KIN(5)[l * NMODW + ch * 64 + nn];
#pragma unroll
            for (int w = 0; w < 8; ++w) s += red[(w * 5 + r) * 64 + nn];
            MOD[(size_t)(l * 5 + r) * NMODW + ch * 64 + nn] = s; }
        __syncthreads();
    }
}

__device__ __forceinline__ void hy_filter_item(const Args& a, int hl, int n, int t0, float* FT, LAS unsigned char* lds, int tid, int wave, int lane) {
    LAS float* bufA = (LAS float*)lds;
    LAS float* bufB = (LAS float*)(lds + 16384);
    typedef CAS const float* cfp;
    const cfp w1 = (cfp)(KIN(16) + hl * 33 * 64); const cfp b1 = (cfp)(KIN(17) + hl * 64); const cfp w2 = (cfp)(KIN(18) + hl * 4096); const cfp b2 = (cfp)(KIN(19) + hl * 64);
    const cfp w3 = (cfp)(KIN(20) + hl * 4096); const cfp b3 = (cfp)(KIN(21) + hl * 64); const cfp w4 = (cfp)(KIN(22) + (size_t)hl * 64 * 2048); const cfp fr = (cfp)(KIN(23) + hl * 64);
    const int t = t0 + lane;
    const float tt = (float)t / (float)(n - 1);
    const float wv = 6.283185307179586f * (float)t / (float)n;
    for (int f = wave; f < 33; f += NWAVES) {
        float v;
        if (f == 0) v = tt;
        else { const int k = (f - 1) & 15; const float band = 1e-4f + (float)k * ((15.0f - 1e-4f) / 15.0f); const float ang = band * wv; v = (f <= 16) ? cosf(ang) : -sinf(ang); }
        bufB[f * 64 + lane] = v;
    }
    __syncthreads();
    const int j0 = wave * 8;
    {
        float in[33];
#pragma unroll
        for (int i = 0; i < 33; ++i) in[i] = bufB[i * 64 + lane];
#pragma unroll
        for (int jj = 0; jj < 8; ++jj) { float acc = b1[j0 + jj];
#pragma unroll
            for (int i = 0; i < 33; ++i) { acc += in[i] * w1[i * 64 + j0 + jj]; }
            bufA[(j0 + jj) * 64 + lane] = sinf(fr[j0 + jj] * acc); }
    }
    __syncthreads();
    {
        float in[64];
#pragma unroll
        for (int i = 0; i < 64; ++i) in[i] = bufA[i * 64 + lane];
#pragma unroll
        for (int jj = 0; jj < 8; ++jj) { float acc = b2[j0 + jj];
#pragma unroll
            for (int i = 0; i < 64; ++i) { acc += in[i] * w2[i * 64 + j0 + jj]; }
            bufB[(j0 + jj) * 64 + lane] = sinf(fr[j0 + jj] * acc); }
    }
    __syncthreads();
    {
        float in[64];
#pragma unroll
        for (int i = 0; i < 64; ++i) in[i] = bufB[i * 64 + lane];
#pragma unroll
        for (int jj = 0; jj < 8; ++jj) { float acc = b3[j0 + jj];
#pragma unroll
            for (int i = 0; i < 64; ++i) { acc += in[i] * w3[i * 64 + j0 + jj]; }
            bufA[(j0 + jj) * 64 + lane] = sinf(fr[j0 + jj] * acc); }
    }
    __syncthreads();
    {
        float in[64];
#pragma unroll
        for (int i = 0; i < 64; ++i) in[i] = bufA[i * 64 + lane];
        const float dmin = -3.0701134573253943f, dmax = -15.350567286626972f;
        for (int nb = 0; nb < 256; nb += 8) {
            const int n0 = wave * 256 + nb;
            float acc[8] = {0.f, 0.f, 0.f, 0.f, 0.f, 0.f, 0.f, 0.f};
#pragma unroll
            for (int i = 0; i < 64; ++i) {
#pragma unroll
                for (int e = 0; e < 8; ++e) acc[e] += in[i] * w4[i * 2048 + n0 + e]; }
#pragma unroll
            for (int e = 0; e < 8; ++e) { const int nn = n0 + e, c = nn & 1023; const float dl = dmin + (float)c * ((dmax - dmin) / 1023.0f);
                FT[(size_t)nn * n + t] = acc[e] * expf(-tt * fabsf(dl)); }
        }
    }
    __syncthreads();
}

__device__ __forceinline__ void prologue(const Args& a, LAS unsigned char* lds, int G, int tid, int wave, int lane) {
    float* TW = (float*)(KWS() + WS_TW);
    for (int m = blockIdx.x * NTHREADS + tid; m < FFTN; m += G * NTHREADS) { const float x = (float)m * (2.0f / (float)FFTN); TW[2 * m] = cospif(x); TW[2 * m + 1] = -sinpif(x); }
    mod_phase(a, lds, G, tid, wave, lane);
    for (int it = blockIdx.x; it < 260; it += G) {
        if (it < 256) hy_filter_item(a, it >> 7, SEQ, (it & 127) * 64, KOUT() + (size_t)(it >> 7) * 2 * 1024 * SEQ, lds, tid, wave, lane);
        else hy_filter_item(a, 0, CTXL, (it - 256) * 64, (float*)(KWS() + WS_FTC), lds, tid, wave, lane);
    }
    convert_layer(a, 0, lds, G, wave, lane, G > 64 ? 4 : 0);
}

#define RN_SBASE(p) asm volatile("" : "+s"(p))
#define RN_LD4(base, j) (*(const f32x4*)((const char*)(base) + lo + 1024u * (j)))
#define RN_LD2(base, j) (*(const u32x2*)((const char*)(base) + (lo >> 1) + 512u * (j)))
#define RN_UNPK(v) ((f32x4){bf_lo((v).x), bf_hi((v).x), bf_lo((v).y), bf_hi((v).y)})
typedef _Float16 h16x2 __attribute__((ext_vector_type(2)));
__device__ __forceinline__ f32x4 x_unpack(u32x2 v) { const unsigned w0 = v.x, w1 = v.y;
    const h16x2 a = __builtin_bit_cast(h16x2, w0), b = __builtin_bit_cast(h16x2, w1); return (f32x4){(float)a.x, (float)a.y, (float)b.x, (float)b.y}; }
__device__ __forceinline__ u32x2 x_pack(f32x4 x) { h16x2 a, b; a.x = (_Float16)x.x; a.y = (_Float16)x.y; b.x = (_Float16)x.z; b.y = (_Float16)x.w; u32x2 o; o.x = __builtin_bit_cast(unsigned, a); o.y = __builtin_bit_cast(unsigned, b); return o; }
__device__ __forceinline__ void rownorm_phase(const Args& a, int G, int rows, bool first, bool writeh, bool final_out, const bf16* Y, float coef,
                                              const float* gate, const float* gpost, const float* shift, const float* scale, const float* gpre, bf16* H, int wave, int lane, bool junk = false, int nks = 0) {
    const bf16* part = (const bf16*)(KWS() + WS_VT);
    bf16* XB = (bf16*)(KWS() + WS_XB);
    const ptrdiff_t jo = junk ? (ptrdiff_t)(((bf16*)(KWS() + WS_Z)) - XB) : 0;
    const unsigned lo = (unsigned)lane * 16u;
    const int gw = blockIdx.x * NWAVES + wave, NGW = G * NWAVES;
    for (int mb = gw; mb < rows; mb += 2 * NGW) {
        int mm[2]; mm[0] = mb; mm[1] = (mb + NGW < rows) ? mb + NGW : mb;
        f32x4 x[2][4]; f32x4 y[2][4]; float ss[2]; int mr[2];
#pragma unroll
        for (int u = 0; u < 2; ++u) {
            const int m = mm[u]; mr[u] = m < MLAT ? (m >> 13) : 4;
            if (first) { const float* src = m < MLAT ? KIN(0) + (size_t)m * D : KIN(2) + (size_t)(m - MLAT) * D;
#pragma unroll
                for (int j = 0; j < 4; ++j) x[u][j] = RN_LD4(src, j);
            } else {
                ss[u] = 0.f;
                const bf16* yrow = Y + (size_t)m * D; const bf16* xrow = XB + (size_t)m * D;
#pragma unroll
                for (int j = 0; j < 4; ++j) { const u32x2 xv = RN_LD2(xrow, j); x[u][j] = x_unpack(xv); }
                if (nks > 0 && m >= MLAT) {
                    const bf16* pp = part + (size_t)(m - MLAT) * D;
#pragma unroll
                    for (int j = 0; j < 4; ++j) y[u][j] = (f32x4){0.f, 0.f, 0.f, 0.f};
                    if (nks == 11) {
                        u32x2 pv[11][4];
#pragma unroll
                        for (int ks = 0; ks < 11; ++ks) { const bf16* pk = pp + (size_t)ks * MCTX * D; RN_SBASE(pk);
#pragma unroll
                            for (int j = 0; j < 4; ++j) pv[ks][j] = RN_LD2(pk, j); }
#pragma unroll
                        for (int ks = 0; ks < 11; ++ks)
#pragma unroll
                            for (int j = 0; j < 4; ++j) y[u][j] = y[u][j] + RN_UNPK(pv[ks][j]);
                    } else {
                        u32x2 pv[4][4];
#pragma unroll
                        for (int ks = 0; ks < 4; ++ks) { const bf16* pk = pp + (size_t)ks * MCTX * D; RN_SBASE(pk);
#pragma unroll
                            for (int j = 0; j < 4; ++j) pv[ks][j] = RN_LD2(pk, j); }
#pragma unroll
                        for (int ks = 0; ks < 4; ++ks)
#pragma unroll
                            for (int j = 0; j < 4; ++j) y[u][j] = y[u][j] + RN_UNPK(pv[ks][j]);
                    }
                } else {
#pragma unroll
                    for (int j = 0; j < 4; ++j) { const u32x2 yv = RN_LD2(yrow, j); y[u][j] = RN_UNPK(yv); }
                }
#pragma unroll
                for (int j = 0; j < 4; ++j) ss[u] += (y[u][j].x * y[u][j].x + y[u][j].y * y[u][j].y) + (y[u][j].z * y[u][j].z + y[u][j].w * y[u][j].w);
            }
        }
        if (!first) {
#pragma unroll
            for (int u = 0; u < 2; ++u) {
                float msq = wave_sum(ss[u], lane) * (1.0f / D); asm volatile("" : "+v"(msq));
                const float rstd = 1.0f / sqrtf(msq + RMS_EPS) * coef;
                const float* grow = gate + (size_t)mr[u] * NMODW; RN_SBASE(grow); const float* gpo = gpost; RN_SBASE(gpo);
#pragma unroll
                for (int j = 0; j < 4; ++j) { const f32x4 g = RN_LD4(grow, j); const f32x4 gp = RN_LD4(gpo, j);
                    x[u][j] = x[u][j] + g * (y[u][j] * rstd) * gp; }
            }
        }
        if (final_out) {
#pragma unroll
            for (int u = 0; u < 2; ++u) { float* orow = KOUT() + (size_t)mm[u] * D; RN_SBASE(orow);
#pragma unroll
                for (int j = 0; j < 4; ++j) *(f32x4*)((char*)orow + lo + 1024u * j) = x[u][j]; }
        } else {
#pragma unroll
            for (int u = 0; u < 2; ++u) {
                bf16* xo = XB + (size_t)mm[u] * D + (mm[u] < MLAT ? jo : 0);
                if (!(junk && mm[u] >= MLAT)) {
#pragma unroll
                    for (int j = 0; j < 4; ++j) *(u32x2*)((char*)xo + (lo >> 1) + 512u * j) = x_pack(x[u][j]);
                }
            }
        }
        if (writeh && !junk) {
#pragma unroll
            for (int u = 0; u < 2; ++u) {
                float s2 = 0.f;
#pragma unroll
                for (int j = 0; j < 4; ++j) s2 += (x[u][j].x * x[u][j].x + x[u][j].y * x[u][j].y) + (x[u][j].z * x[u][j].z + x[u][j].w * x[u][j].w);
                float msq = wave_sum(s2, lane) * (1.0f / D); asm volatile("" : "+v"(msq));
                const float rstd = 1.0f / sqrtf(msq + RMS_EPS);
                const float* srow = scale + (size_t)mr[u] * NMODW; const float* hrow = shift + (size_t)mr[u] * NMODW; bf16* hout = H + (size_t)mm[u] * D; const float* gpr = gpre;
                RN_SBASE(srow); RN_SBASE(hrow); RN_SBASE(hout); RN_SBASE(gpr);
#pragma unroll
                for (int j = 0; j < 4; ++j) { const f32x4 gp = RN_LD4(gpr, j); const f32x4 sc = RN_LD4(srow, j); const f32x4 sh = RN_LD4(hrow, j);
                    const f32x4 h = (x[u][j] * rstd * gp) * (sc + 1.0f) + sh; u32x2 o; o.x = pk2(h.x, h.y); o.y = pk2(h.z, h.w); *(u32x2*)((char*)hout + (lo >> 1) + 512u * j) = o; }
            }
        }
    }
}


__device__ __forceinline__ f32x4 mfma16(bf16x8 a, bf16x8 b, f32x4 c) { return __builtin_amdgcn_mfma_f32_16x16x32_bf16(a, b, c, 0, 0, 0); }

constexpr int AB_KC = 0, AB_VC = 256 * 144, AB_RP = AB_VC + 64 * 528, AB_LDS_END = AB_RP + 15 * 31 * 4;
template <bool CTXQ>
__device__ __forceinline__ void attn_item(const bf16* __restrict__ Z, const bf16* __restrict__ VT, const float* __restrict__ rpb, bf16* MIX, int b, int r, int head, int qg, int lane, const LAS unsigned char* lc) {
    const int l15 = lane & 15, quad = lane >> 4;
    constexpr int NT = CTXQ ? 16 : 32;
    const int c0 = qg * 16;
    const int kc0 = min(max(c0 - 8, 0), 32);
    const int row_start = min(max(r - 4, 0), 120);
    const char* zlat = (const char*)(Z + (size_t)b * SEQ * ZW + head * 64);
    const char* zctx = (const char*)(Z + ((size_t)MLAT + b * CTXL) * ZW + head * 64);
    const unsigned lrow = (unsigned)(l15 * ZW + quad * 8) * 2u;
    const unsigned qoff = CTXQ ? (unsigned)(qg * 16 * ZW) * 2u + lrow : (unsigned)((r * 64 + c0) * ZW) * 2u + lrow;
    const char* qb = CTXQ ? zctx : zlat;
    const bf16x8 q0 = *(const bf16x8*)(qb + qoff), q1 = *(const bf16x8*)(qb + qoff + 64);
    f32x4 s[NT];
    const int krel = (l15 >> 2) * 8 + (l15 & 3);
    const unsigned krow = (unsigned)(krel * ZW + quad * 8) * 2u;
    const unsigned kwin = (unsigned)((row_start * 64 + kc0) * ZW + 512) * 2u + krow;
#pragma unroll
    for (int t = 0; t < NT; ++t) {
        bf16x8 k0, k1;
        if (!CTXQ && t < 16) { const unsigned o = kwin + (unsigned)(((t >> 1) * 64 + (t & 1) * 4) * ZW) * 2u; k0 = *(const bf16x8*)(zlat + o); k1 = *(const bf16x8*)(zlat + o + 64); }
        else if (CTXQ) { const unsigned o = (unsigned)(((t >> 1) * 32 + (t & 1) * 4) * ZW + 512) * 2u + krow; k0 = *(const bf16x8*)(zctx + o); k1 = *(const bf16x8*)(zctx + o + 64); }
        else { const LAS unsigned char* kp = lc + AB_KC + (((t - 16) >> 1) * 32 + (t & 1) * 4 + krel) * 144 + quad * 16; k0 = *(const LAS bf16x8*)kp; k1 = *(const LAS bf16x8*)(kp + 64); }
        f32x4 acc = {0.f, 0.f, 0.f, 0.f};
        acc = mfma16(k0, q0, acc); acc = mfma16(k1, q1, acc);
        s[t] = acc;
    }
    const int qc = c0 + l15, st = min(max(qc - 8, 0), 48);
    float mx = -INFINITY;
#pragma unroll
    for (int t = 0; t < NT; ++t)
#pragma unroll
        for (int jj = 0; jj < 4; ++jj) {
            float v = s[t][jj] * 0.125f;
            if (!CTXQ && t < 16) {
                const int kc = kc0 + quad * 8 + (t & 1) * 4 + jj;
                const bool valid = (kc >= st) && (kc < st + 16);
                const int dy = row_start + (t >> 1) - r + 7;
                const int dx = min(max(kc - qc + 15, 0), 30);
                const float bias = *(const LAS float*)(lc + AB_RP + (dy * 31 + dx) * 4);
                v = valid ? v + bias : -INFINITY;
            }
            s[t][jj] = v; mx = fmaxf(mx, v);
        }
    mx = fmaxf(mx, lane_xor_f(mx, 16, lane)); mx = fmaxf(mx, lane_xor_f(mx, 32, lane));
    float sum = 0.f;
#pragma unroll
    for (int t = 0; t < NT; ++t)
#pragma unroll
        for (int jj = 0; jj < 4; ++jj) { const float p = __expf(s[t][jj] - mx); s[t][jj] = p; sum += p; }
    sum += lane_xor_f(sum, 16, lane); sum += lane_xor_f(sum, 32, lane);
    f32x4 o[4];
#pragma unroll
    for (int dt = 0; dt < 4; ++dt) o[dt] = (f32x4){0.f, 0.f, 0.f, 0.f};
    const char* vb = (const char*)(VT + (size_t)(head * 64) * MTOT);
    const unsigned vrow = (unsigned)(l15 * MTOT + quad * 8) * 2u;
    const unsigned vwin = (unsigned)(b * SEQ + row_start * 64 + kc0) * 2u + vrow, vctx = (unsigned)(MLAT + b * CTXL) * 2u + vrow;
#pragma unroll
    for (int ks = 0; ks < NT / 2; ++ks) {
        u32x4 pw; pw.x = pk2(s[2 * ks][0], s[2 * ks][1]); pw.y = pk2(s[2 * ks][2], s[2 * ks][3]); pw.z = pk2(s[2 * ks + 1][0], s[2 * ks + 1][1]); pw.w = pk2(s[2 * ks + 1][2], s[2 * ks + 1][3]);
        const bf16x8 pa = __builtin_bit_cast(bf16x8, pw);
        unsigned co;
        if (!CTXQ && ks < 8) co = vwin + (unsigned)(ks * 64) * 2u; else co = vctx + (unsigned)((2 * ks - (CTXQ ? 0 : 16)) * 16) * 2u;
#pragma unroll
        for (int dt = 0; dt < 4; ++dt) {
            bf16x8 vw;
            if (!CTXQ && ks >= 8) vw = *(const LAS bf16x8*)(lc + AB_VC + (dt * 16 + l15) * 528 + ((2 * ks - 16) * 16 + quad * 8) * 2);
            else vw = *(const bf16x8*)(vb + co + (unsigned)(dt * 16 * MTOT) * 2u);
            o[dt] = mfma16(vw, pa, o[dt]);
        }
    }
    bf16* ob = CTXQ ? MIX + ((size_t)MLAT + b * CTXL + qg * 16) * D + head * 64 : MIX + ((size_t)b * SEQ + r * 64 + c0) * D + head * 64;
    const float inv = 1.0f / sum;
#pragma unroll
    for (int dt = 0; dt < 4; ++dt) { u32x2 w; w.x = pk2(o[dt][0] * inv, o[dt][1] * inv); w.y = pk2(o[dt][2] * inv, o[dt][3] * inv);
        *(u32x2*)(ob + (unsigned)(l15 * D + dt * 16 + quad * 4)) = w; }
}

__device__ __forceinline__ void ab_core_phase(const Args& a, int l, LAS unsigned char* lds, int G, int tid, int wave, int lane) {
    const bf16* Z = (const bf16*)(KWS() + WS_Z); const bf16* VT = (const bf16*)(KWS() + WS_VT); bf16* MIX = (bf16*)(KWS() + WS_H);
    const int j = l >> 1;
    const float* rpb = KIN(11) + (size_t)j * 8 * 15 * 31;
    const float* cw = KIN(12) + (size_t)j * 3 * 512;
    const bool ctxq = (l == 0);
    const int gw = blockIdx.x * NWAVES + wave, NGW = G * NWAVES;
    for (int job = blockIdx.x; job < NB * 8 * 8; job += G) {
        const int b = job >> 6, head = (job >> 3) & 7, r0 = (job & 7) * 16;
        __syncthreads();
        for (int e = tid; e < 2048; e += NTHREADS) { const int jj = e >> 3, c = e & 7;
            *(LAS u32x4*)(lds + AB_KC + jj * 144 + c * 16) = *(const u32x4*)(Z + ((size_t)MLAT + b * CTXL + jj) * ZW + 512 + head * 64 + c * 8); }
        for (int e = tid; e < 2048; e += NTHREADS) { const int d = e >> 5, c = e & 31;
            *(LAS u32x4*)(lds + AB_VC + d * 528 + c * 16) = *(const u32x4*)(VT + (size_t)(head * 64 + d) * MTOT + MLAT + b * CTXL + c * 8); }
        if (tid < 15 * 31) *(LAS float*)(lds + AB_RP + tid * 4) = rpb[head * 15 * 31 + tid];
        __syncthreads();
        for (int i = wave; i < 64; i += NWAVES) attn_item<false>(Z, VT, rpb, MIX, b, r0 + (i >> 2), head, i & 3, lane, lds);
    }
    if (ctxq) for (int it = gw; it < NB * 8 * 16; it += NGW) attn_item<true>(Z, VT, rpb, MIX, it >> 7, 0, (it >> 4) & 7, it & 15, lane, lds);
    const int rows = ctxq ? MTOT : MLAT;
#pragma unroll 4
    for (int idx = blockIdx.x * NTHREADS + tid; idx < rows * 64; idx += G * NTHREADS) {
        const int m = idx >> 6, ch = (idx & 63) * 8;
        const int pos = m < MLAT ? (m & (SEQ - 1)) : ((m - MLAT) & (CTXL - 1)); const int len = m < MLAT ? SEQ : CTXL;
        const bf16* zr = Z + (size_t)m * ZW;
        float acc[8] = {0.f, 0.f, 0.f, 0.f, 0.f, 0.f, 0.f, 0.f};
#pragma unroll
        for (int d = 0; d < 3; ++d) {
            const int p = pos + d - 1;
            if (p >= 0 && p < len) {
                const u32x4 gcv = *(const u32x4*)(zr + (ptrdiff_t)(d - 1) * ZW + 2048 + ch), xbv = *(const u32x4*)(zr + (ptrdiff_t)(d - 1) * ZW + 2560 + ch);
                float gc[8], xb[8]; UNPACK8(gcv, gc); UNPACK8(xbv, xb);
#pragma unroll
                for (int e = 0; e < 8; ++e) acc[e] += cw[d * 512 + ch + e] * (gc[e] * xb[e]);
            }
        }
        const u32x4 gbv = *(const u32x4*)(zr + 1536 + ch); float gb[8]; UNPACK8(gbv, gb);
        u32x4 o; o.x = pk2(gb[0] * acc[0], gb[1] * acc[1]); o.y = pk2(gb[2] * acc[2], gb[3] * acc[3]); o.z = pk2(gb[4] * acc[4], gb[5] * acc[5]); o.w = pk2(gb[6] * acc[6], gb[7] * acc[7]);
        *(u32x4*)(MIX + (size_t)m * D + 512 + ch) = o;
    }
}

__device__ __forceinline__ void shortconv8(const bf16* __restrict__ Z, size_t rowbase, int pos, int len, int col, const float* __restrict__ sw, float (&out)[8]) {
#pragma unroll
    for (int e = 0; e < 8; ++e) out[e] = 0.f;
#pragma unroll
    for (int d = 0; d < 3; ++d) {
        const int p = pos + d - 1;
        if (p >= 0 && p < len) {
            const u32x4 zv = *(const u32x4*)(Z + (rowbase + p) * ZW + col); float z[8]; UNPACK8(zv, z);
            const f32x4 w0 = *(const f32x4*)(sw + d * ZW + col), w1 = *(const f32x4*)(sw + d * ZW + col + 4);
            out[0] += w0.x * z[0]; out[1] += w0.y * z[1]; out[2] += w0.z * z[2]; out[3] += w0.w * z[3];
            out[4] += w1.x * z[4]; out[5] += w1.y * z[5]; out[6] += w1.z * z[6]; out[7] += w1.w * z[7];
        }
    }
}
constexpr int HY_TT = 256, HY_TP = HY_TT + 1;
__device__ __forceinline__ void hy_pre_phase(const Args& a, int l, LAS unsigned char* lds, int G, int tid) {
    const bf16* Z = (const bf16*)(KWS() + WS_Z); bf16* UT = (bf16*)(KWS() + WS_Y);
    const float* sw = KIN(15) + (size_t)(l >> 1) * 3 * ZW;
    LAS float* T = (LAS float*)lds;
    for (int it = blockIdx.x; it < NB * (SEQ / HY_TT) * 16; it += G) {
        const int b = it >> 9, t0 = ((it >> 4) & 31) * HY_TT, c0 = (it & 15) * 64;
#pragma unroll 2
        for (int e = tid; e < HY_TT * 8; e += NTHREADS) {
            const int tl = e >> 3, cc = (e & 7) * 8; float x1[8], v[8];
            shortconv8(Z, (size_t)b * SEQ, t0 + tl, SEQ, 1024 + c0 + cc, sw, x1);
            shortconv8(Z, (size_t)b * SEQ, t0 + tl, SEQ, 2048 + c0 + cc, sw, v);
#pragma unroll
            for (int i = 0; i < 8; ++i) T[(cc + i) * HY_TP + tl] = x1[i] * v[i];
        }
        __syncthreads();
        for (int e = tid; e < 64 * (HY_TT / 8); e += NTHREADS) {
            const int c = e >> 5, tch = (e & 31) * 8; const LAS float* s = T + c * HY_TP + tch;
            u32x4 o; o.x = pk2(s[0], s[1]); o.y = pk2(s[2], s[3]); o.z = pk2(s[4], s[5]); o.w = pk2(s[6], s[7]);
            *(u32x4*)(UT + ((size_t)(b * 1024 + c0 + c)) * SEQ + t0 + tch) = o;
        }
        __syncthreads();
    }
}
__device__ __forceinline__ void hy_post_phase(const Args& a, int l, LAS unsigned char* lds, int G, int tid) {
    const bf16* Z = (const bf16*)(KWS() + WS_Z); const bf16* UT = (const bf16*)(KWS() + WS_Y); bf16* MIX = (bf16*)(KWS() + WS_H);
    const float* sw = KIN(15) + (size_t)(l >> 1) * 3 * ZW;
    LAS float* T = (LAS float*)lds;
    for (int it = blockIdx.x; it < NB * (SEQ / HY_TT) * 16; it += G) {
        const int b = it >> 9, t0 = ((it >> 4) & 31) * HY_TT, c0 = (it & 15) * 64;
#pragma unroll 2
        for (int e = tid; e < 64 * (HY_TT / 8); e += NTHREADS) {
            const int c = e >> 5, tch = (e & 31) * 8;
            const u32x4 uv = *(const u32x4*)(UT + ((size_t)(b * 1024 + c0 + c)) * SEQ + t0 + tch); float f[8]; UNPACK8(uv, f);
#pragma unroll
            for (int i = 0; i < 8; ++i) T[c * HY_TP + tch + i] = f[i];
        }
        __syncthreads();
#pragma unroll 2
        for (int e = tid; e < HY_TT * 8; e += NTHREADS) {
            const int tl = e >> 3, cc = (e & 7) * 8; float x0[8];
            shortconv8(Z, (size_t)b * SEQ, t0 + tl, SEQ, c0 + cc, sw, x0);
            float y[8];
#pragma unroll
            for (int i = 0; i < 8; ++i) y[i] = x0[i] * T[(cc + i) * HY_TP + tl];
            u32x4 o; o.x = pk2(y[0], y[1]); o.y = pk2(y[2], y[3]); o.z = pk2(y[4], y[5]); o.w = pk2(y[6], y[7]);
            *(u32x4*)(MIX + ((size_t)b * SEQ + t0 + tl) * D + c0 + cc) = o;
        }
        __syncthreads();
    }
}

typedef float cf2 __attribute__((ext_vector_type(2)));
__device__ __forceinline__ cf2 mk2(float x, float y) { cf2 r; r.x = x; r.y = y; return r; }
#define FFT_HD __device__ __forceinline__
#define FFT_CX LAS
#define FFT_LAUNDER(x) asm volatile("" : "+v"(x))
FFT_HD cf2 c_add(cf2 a, cf2 b) { return mk2(a.x + b.x, a.y + b.y); }
FFT_HD cf2 c_sub(cf2 a, cf2 b) { return mk2(a.x - b.x, a.y - b.y); }
FFT_HD cf2 c_mul(cf2 a, cf2 b) { return mk2(a.x * b.x - a.y * b.y, a.x * b.y + a.y * b.x); }
FFT_HD cf2 c_mulc(cf2 a, cf2 b) { return mk2(a.x * b.x + a.y * b.y, a.y * b.x - a.x * b.y); }
template <bool INV> FFT_HD cf2 c_rot(cf2 a) { return INV ? mk2(-a.y, a.x) : mk2(a.y, -a.x); }
template <bool INV> FFT_HD cf2 c_tw(cf2 a, float c, float s) { return INV ? mk2(a.x * c + a.y * s, a.y * c - a.x * s) : mk2(a.x * c - a.y * s, a.x * s + a.y * c); }
template <bool INV> FFT_HD void bf4(cf2& a0, cf2& a1, cf2& a2, cf2& a3) {
    const cf2 t0 = c_add(a0, a2), t1 = c_sub(a0, a2), t2 = c_add(a1, a3), t3 = c_rot<INV>(c_sub(a1, a3));
    a0 = c_add(t0, t2); a1 = c_add(t1, t3); a2 = c_sub(t0, t2); a3 = c_sub(t1, t3);
}
template <bool INV> FFT_HD void dft16(cf2 (&a)[16]) {
#pragma unroll
    for (int q2 = 0; q2 < 4; ++q2) bf4<INV>(a[q2], a[q2 + 4], a[q2 + 8], a[q2 + 12]);
    float C1 = 0.92387953251128674f, C2 = 0.70710678118654752f, C3 = 0.38268343236508977f;
    FFT_LAUNDER(C1); FFT_LAUNDER(C2); FFT_LAUNDER(C3);
    const float S1 = -C3, S2 = -C2, S3 = -C1;
    a[1 + 4] = c_tw<INV>(a[1 + 4], C1, S1); a[1 + 8] = c_tw<INV>(a[1 + 8], C2, S2); a[1 + 12] = c_tw<INV>(a[1 + 12], C3, S3);
    a[2 + 4] = c_tw<INV>(a[2 + 4], C2, S2); a[2 + 8] = c_rot<INV>(a[2 + 8]);        a[2 + 12] = c_tw<INV>(a[2 + 12], -C2, S2);
    a[3 + 4] = c_tw<INV>(a[3 + 4], C3, S3); a[3 + 8] = c_tw<INV>(a[3 + 8], -C2, S2); a[3 + 12] = c_tw<INV>(a[3 + 12], -C1, -S1);
#pragma unroll
    for (int r1 = 0; r1 < 4; ++r1) bf4<INV>(a[4 * r1], a[4 * r1 + 1], a[4 * r1 + 2], a[4 * r1 + 3]);
}
#define FFT_PERM(r) ((((r) & 3) << 2) | ((r) >> 2))
#define FFT_PHYS(n) ((n) + ((n) >> 4))
FFT_HD void tw_pow16(cf2 w1, cf2 (&w)[16]) {
    w[0] = mk2(1.f, 0.f); w[1] = w1; w[2] = c_mul(w1, w1); w[3] = c_mul(w[2], w1); w[4] = c_mul(w[2], w[2]); w[5] = c_mul(w[4], w1); w[6] = c_mul(w[3], w[3]); w[7] = c_mul(w[4], w[3]);
    w[8] = c_mul(w[4], w[4]);
#pragma unroll
    for (int r = 9; r < 16; ++r) w[r] = c_mul(w[8], w[r - 8]);
}
FFT_HD void r16_fwd(FFT_CX cf2* cx, int base, int stride, cf2 w1, bool notw) {
    cf2 a[16];
#pragma unroll
    for (int q = 0; q < 16; ++q) a[q] = cx[base + q * stride];
    dft16<false>(a);
    if (notw) {
#pragma unroll
        for (int r = 0; r < 16; ++r) cx[base + r * stride] = a[FFT_PERM(r)];
    } else {
        cf2 w[16]; tw_pow16(w1, w);
#pragma unroll
        for (int r = 0; r < 16; ++r) cx[base + r * stride] = r == 0 ? a[0] : c_mul(a[FFT_PERM(r)], w[r]);
    }
}
FFT_HD void r16_inv(FFT_CX cf2* cx, int base, int stride, cf2 w1) {
    cf2 a[16]; cf2 w[16]; tw_pow16(w1, w);
#pragma unroll
    for (int r = 0; r < 16; ++r) { const cf2 v = cx[base + r * stride]; a[r] = r == 0 ? v : c_mulc(v, w[r]); }
    dft16<true>(a);
#pragma unroll
    for (int q = 0; q < 16; ++q) cx[base + q * stride] = a[FFT_PERM(q)];
}
__device__ __forceinline__ void hy_fft_phase(const Args& a, int l, LAS unsigned char* lds, int G, int tid, bool junk) {
    const int hl = l >> 1;
    bf16* UT = (bf16*)(KWS() + WS_Y); const ptrdiff_t dsto = junk ? (ptrdiff_t)(WS_H / 2) - (ptrdiff_t)(WS_Y / 2) : 0;
    const float* FT = (const float*)KOUT() + (size_t)hl * 2 * 1024 * SEQ;
    const cf2* TW = (const cf2*)(KWS() + WS_TW);
    cf2* KF = (cf2*)(KWS() + WS_KFS) + (size_t)blockIdx.x * FFTN;
    const float* bias = KIN(24) + hl * 1024;
    LAS cf2* cx = (LAS cf2*)lds;
    cf2 tw0[8];
#pragma unroll
    for (int k = 0; k < 8; ++k) tw0[k] = TW[8 * tid + k];
    const cf2 tw1 = TW[4 * (tid & 255)], tw2 = TW[64 * (tid & 15)];
    for (int c = blockIdx.x; c < 1024; c += G) {
        const float* hf = FT + (size_t)c * SEQ; const float* hb = FT + (size_t)(1024 + c) * SEQ;
#pragma unroll
        for (int k = 0; k < 8; ++k) {
            int t_ = tid; asm volatile("" : "+v"(t_)); const int j = 8 * t_ + k;
            const unsigned jb = (unsigned)j * 4u;
            cf2 a0 = mk2(*(const float*)((const char*)hf + jb), 0.f), a1 = mk2(*(const float*)((const char*)hf + jb + 16384u), 0.f), a2 = mk2(j == 0 ? 0.f : *(const float*)((const char*)hb + (32768u - jb)), 0.f), a3 = mk2(*(const float*)((const char*)hb + (16384u - jb)), 0.f);
            bf4<false>(a0, a1, a2, a3);
            cf2 w1 = tw0[k]; asm volatile("" : "+v"(w1)); const cf2 w2 = c_mul(w1, w1), w3 = c_mul(w2, w1);
            { const int pj = FFT_PHYS(j); cx[pj] = a0; cx[pj + 4352] = c_mul(a1, w1); cx[pj + 8704] = c_mul(a2, w2); cx[pj + 13056] = c_mul(a3, w3); }
        }
        __syncthreads();
#pragma unroll
        for (int k = 0; k < 2; ++k) { int t_ = tid; asm volatile("" : "+v"(t_)); const int i = t_ + 512 * k, n_ = (i >> 8) * 4096 + (i & 255); cf2 w_ = tw1; asm volatile("" : "+v"(w_)); r16_fwd(cx, FFT_PHYS(n_), 272, w_, false); }
        __syncthreads();
#pragma unroll
        for (int k = 0; k < 2; ++k) { int t_ = tid; asm volatile("" : "+v"(t_)); const int i = t_ + 512 * k, n_ = (i >> 4) * 256 + (i & 15); cf2 w_ = tw2; asm volatile("" : "+v"(w_)); r16_fwd(cx, FFT_PHYS(n_), 17, w_, false); }
        LDS_WAIT(); asm volatile("" ::: "memory");
#pragma unroll
        for (int k = 0; k < 2; ++k) {
            int t_ = tid; asm volatile("" : "+v"(t_)); const int i = t_ + 512 * k; cf2 v[16];
#pragma unroll
            for (int q = 0; q < 16; ++q) v[q] = cx[17 * i + q];
            dft16<false>(v);
#pragma unroll
            for (int r = 0; r < 16; ++r) { const cf2 y = v[FFT_PERM(r)]; *(cf2*)((char*)KF + (unsigned)i * 128u + r * 8) = mk2(y.x * (1.0f / FFTN), y.y * (1.0f / FFTN)); }
        }
        __syncthreads();
        const float bc = bias[c];
        for (int pair = 0; pair < 2; ++pair) {
            bf16* u0 = UT + ((size_t)((2 * pair) * 1024 + c)) * SEQ; bf16* u1 = UT + ((size_t)((2 * pair + 1) * 1024 + c)) * SEQ;
            {
                int t_ = tid; asm volatile("" : "+v"(t_)); const unsigned jb = (unsigned)t_ * 16u; const int pj0 = 8 * t_ + (t_ >> 1);
                const u32x4 A0 = *(const u32x4*)((const char*)u0 + jb), A1 = *(const u32x4*)((const char*)u1 + jb), B0 = *(const u32x4*)((const char*)u0 + jb + 8192u), B1 = *(const u32x4*)((const char*)u1 + jb + 8192u);
                float fa0[8], fa1[8], fb0[8], fb1[8]; UNPACK8(A0, fa0); UNPACK8(A1, fa1); UNPACK8(B0, fb0); UNPACK8(B1, fb1);
#pragma unroll
                for (int k = 0; k < 8; ++k) {
                    cf2 a0 = mk2(fa0[k], fa1[k]), a1 = mk2(fb0[k], fb1[k]), a2 = mk2(0.f, 0.f), a3 = mk2(0.f, 0.f);
                    bf4<false>(a0, a1, a2, a3);
                    cf2 w1 = tw0[k]; asm volatile("" : "+v"(w1)); const cf2 w2 = c_mul(w1, w1), w3 = c_mul(w2, w1);
                    cx[pj0 + k] = a0; cx[pj0 + k + 4352] = c_mul(a1, w1); cx[pj0 + k + 8704] = c_mul(a2, w2); cx[pj0 + k + 13056] = c_mul(a3, w3);
                }
            }
            __syncthreads();
#pragma unroll
            for (int k = 0; k < 2; ++k) { int t_ = tid; asm volatile("" : "+v"(t_)); const int i = t_ + 512 * k, n_ = (i >> 8) * 4096 + (i & 255); cf2 w_ = tw1; asm volatile("" : "+v"(w_)); r16_fwd(cx, FFT_PHYS(n_), 272, w_, false); }
            __syncthreads();
#pragma unroll
            for (int k = 0; k < 2; ++k) { int t_ = tid; asm volatile("" : "+v"(t_)); const int i = t_ + 512 * k, n_ = (i >> 4) * 256 + (i & 15); cf2 w_ = tw2; asm volatile("" : "+v"(w_)); r16_fwd(cx, FFT_PHYS(n_), 17, w_, false); }
            LDS_WAIT(); asm volatile("" ::: "memory");
#pragma unroll
            for (int k = 0; k < 2; ++k) {
                int t_ = tid; asm volatile("" : "+v"(t_)); const int i = t_ + 512 * k; cf2 v[16], w[16];
#pragma unroll
                for (int q = 0; q < 16; ++q) v[q] = cx[17 * i + q];
                dft16<false>(v);
#pragma unroll
                for (int r = 0; r < 16; ++r) w[r] = c_mul(v[FFT_PERM(r)], *(const cf2*)((const char*)KF + (unsigned)i * 128u + r * 8));
                dft16<true>(w);
#pragma unroll
                for (int q = 0; q < 16; ++q) cx[17 * i + q] = w[FFT_PERM(q)];
            }
            LDS_WAIT(); asm volatile("" ::: "memory");
#pragma unroll
            for (int k = 0; k < 2; ++k) { int t_ = tid; asm volatile("" : "+v"(t_)); const int i = t_ + 512 * k, n_ = (i >> 4) * 256 + (i & 15); cf2 w_ = tw2; asm volatile("" : "+v"(w_)); r16_inv(cx, FFT_PHYS(n_), 17, w_); }
            __syncthreads();
#pragma unroll
            for (int k = 0; k < 2; ++k) { int t_ = tid; asm volatile("" : "+v"(t_)); const int i = t_ + 512 * k, n_ = (i >> 8) * 4096 + (i & 255); cf2 w_ = tw1; asm volatile("" : "+v"(w_)); r16_inv(cx, FFT_PHYS(n_), 272, w_); }
            __syncthreads();
            {
                int t_ = tid; asm volatile("" : "+v"(t_)); const unsigned jb = (unsigned)t_ * 16u; const int pj0 = 8 * t_ + (t_ >> 1);
                const u32x4 A0 = *(const u32x4*)((const char*)u0 + jb), A1 = *(const u32x4*)((const char*)u1 + jb), B0 = *(const u32x4*)((const char*)u0 + jb + 8192u), B1 = *(const u32x4*)((const char*)u1 + jb + 8192u);
                float fa0[8], fa1[8], fb0[8], fb1[8]; UNPACK8(A0, fa0); UNPACK8(A1, fa1); UNPACK8(B0, fb0); UNPACK8(B1, fb1);
#pragma unroll
                for (int k = 0; k < 8; ++k) {
                    cf2 w1 = tw0[k]; asm volatile("" : "+v"(w1)); const cf2 w2 = c_mul(w1, w1), w3 = c_mul(w2, w1);
                    cf2 b0 = cx[pj0 + k], b1 = c_mulc(cx[pj0 + k + 4352], w1), b2 = c_mulc(cx[pj0 + k + 8704], w2), b3 = c_mulc(cx[pj0 + k + 13056], w3);
                    bf4<true>(b0, b1, b2, b3);
                    fa0[k] = b0.x + fa0[k] * bc; fa1[k] = b0.y + fa1[k] * bc; fb0[k] = b1.x + fb0[k] * bc; fb1[k] = b1.y + fb1[k] * bc;
                }
                char* d0 = (char*)(u0 + dsto); char* d1 = (char*)(u1 + dsto);
                u32x4 o; o.x = pk2(fa0[0], fa0[1]); o.y = pk2(fa0[2], fa0[3]); o.z = pk2(fa0[4], fa0[5]); o.w = pk2(fa0[6], fa0[7]); *(u32x4*)(d0 + jb) = o;
                o.x = pk2(fa1[0], fa1[1]); o.y = pk2(fa1[2], fa1[3]); o.z = pk2(fa1[4], fa1[5]); o.w = pk2(fa1[6], fa1[7]); *(u32x4*)(d1 + jb) = o;
                o.x = pk2(fb0[0], fb0[1]); o.y = pk2(fb0[2], fb0[3]); o.z = pk2(fb0[4], fb0[5]); o.w = pk2(fb0[6], fb0[7]); *(u32x4*)(d0 + jb + 8192u) = o;
                o.x = pk2(fb1[0], fb1[1]); o.y = pk2(fb1[2], fb1[3]); o.z = pk2(fb1[4], fb1[5]); o.w = pk2(fb1[6], fb1[7]); *(u32x4*)(d1 + jb + 8192u) = o;
            }
            __syncthreads();
        }
    }
}
__device__ __forceinline__ void hy_ctx_phase(const Args& a, int l, LAS unsigned char* lds, int G, int tid) {
    const int hl = l >> 1;
    const bf16* Z = (const bf16*)(KWS() + WS_Z); bf16* MIX = (bf16*)(KWS() + WS_H);
    const float* sw = KIN(15) + (size_t)hl * 3 * ZW; const float* FTC = (const float*)(KWS() + WS_FTC); const float* bias = KIN(24) + hl * 1024;
    LAS float* U = (LAS float*)lds;
    LAS float* KK = (LAS float*)(lds + 16384);
    for (int it = blockIdx.x; it < NB * 64; it += G) {
        const int b = it >> 6, c0 = (it & 63) * 16; const size_t rb = (size_t)MLAT + b * CTXL;
        { const int jpos = tid >> 1, cc = (tid & 1) * 8; float x1[8], v[8];
            shortconv8(Z, rb, jpos, CTXL, 1024 + c0 + cc, sw, x1); shortconv8(Z, rb, jpos, CTXL, 2048 + c0 + cc, sw, v);
#pragma unroll
            for (int i = 0; i < 8; ++i) U[jpos * 16 + cc + i] = x1[i] * v[i]; }
        for (int e = tid; e < 16 * 511; e += NTHREADS) { const int cch = e / 511, d = e % 511 - 255;
            KK[(d + 263) * 17 + cch] = d >= 0 ? FTC[(size_t)(c0 + cch) * CTXL + d] : FTC[(size_t)(1024 + c0 + cch) * CTXL - d]; }
        __syncthreads();
        const int cc = tid & 15, t0 = (tid >> 4) * 8;
        float acc[8] = {0.f, 0.f, 0.f, 0.f, 0.f, 0.f, 0.f, 0.f};
        for (int j0 = 0; j0 < CTXL; j0 += 8) {
            float k16[15], u8[8];
#pragma unroll
            for (int m = 0; m < 15; ++m) k16[m] = KK[(t0 - j0 - 7 + m + 263) * 17 + cc];
#pragma unroll
            for (int s = 0; s < 8; ++s) u8[s] = U[(j0 + s) * 16 + cc];
#pragma unroll
            for (int s = 0; s < 8; ++s)
#pragma unroll
                for (int i = 0; i < 8; ++i) acc[i] += k16[7 - s + i] * u8[s];
        }
#pragma unroll
        for (int i = 0; i < 8; ++i) {
            const int t = t0 + i; float x0 = 0.f;
#pragma unroll
            for (int d = 0; d < 3; ++d) { const int p = t + d - 1; if (p >= 0 && p < CTXL) x0 += sw[d * ZW + c0 + cc] * bf1(Z[(rb + p) * ZW + c0 + cc]); }
            MIX[(rb + t) * D + c0 + cc] = f2bf(x0 * (acc[i] + U[t * 16 + cc] * bias[c0 + cc]));
        }
        __syncthreads();
    }
}

__global__ void __launch_bounds__(NTHREADS, 2) fwd_megakernel(Args a) {
    extern __shared__ __attribute__((aligned(16))) unsigned char lds_raw[];
    LAS unsigned char* lds = (LAS unsigned char*)lds_raw;
    cg::grid_group grid = cg::this_grid();
    volatile LAS unsigned* misc = (volatile LAS unsigned*)(lds + 139264);
    if (threadIdx.x < 64) misc[threadIdx.x] = 0u;
    __syncthreads();
    (void)xcd_barrier_post((unsigned*)(KWS() + WS_BAR), misc + 8);
#define GRID_BARRIER() do { XcdBarrier xb_; xb_.bar = (unsigned*)(KWS() + WS_BAR); xb_.x = xb_xcc_id(); xb_.st = (volatile LAS unsigned*)(lds + 139264) + 8; xcd_barrier(xb_); } while (0)
    const int G = gridDim.x;
#define FRESH_TID() int tid = threadIdx.x; asm volatile("" : "+v"(tid)); const int lane = tid & 63, wave = __builtin_amdgcn_readfirstlane(tid >> 6)
#undef ws
#define ws KWS()
#define H ((bf16*)(ws + WS_H))
#define Y ((bf16*)(ws + WS_Y))
#define Zb ((bf16*)(ws + WS_Z))
#define VT ((bf16*)(ws + WS_VT))
#define MOD ((const float*)(ws + WS_MOD))
#define NG KIN(6)

    { FRESH_TID();
#ifndef SKIP_PRO
    for (int rep = 0; rep < REP_PRO; ++rep) prologue(a, lds, G, tid, wave, lane);
#endif
    }
    if (gridDim.x == 0x7fffffffu) grid.sync();
    GRID_BARRIER();
    { FRESH_TID();
    for (int rep = 0; rep < REP_R0; ++rep) rownorm_phase(a, G, MTOT, true, true, false, nullptr, 0.f, nullptr, nullptr, MOD + 0 * 1024, MOD + 1 * 1024, NG + 0 * D, H, wave, lane);
    }
    GRID_BARRIER();

    for (int l = 0; l < 4; ++l) {
        const bool even = !(l & 1);
        const int rows1 = (l <= 2) ? MTOT : MLAT, rows2 = (l < 2) ? MTOT : MLAT;
        const float* modl = MOD + (size_t)l * 5 * NMODW; const float* ng = NG + (size_t)l * 6 * D;
        const unsigned long long prog = even ? 0xBA98764321ull : 0xBA987EDC4321ull;
        const int nsteps = even ? 10 : 12;
        for (int s2 = 0; s2 < nsteps * REP_MAX; ++s2) {
            const int s = s2 / REP_MAX, rep = s2 % REP_MAX;
            const int kind = (int)((prog >> (4 * s)) & 15ull);
            {
                const bool isgemm = (kind == 1 || kind == 9 || kind == 2 || kind == 10 || kind == 4 || kind == 5 || kind == 7);
                const int nrep = isgemm ? REP_GEMM : (kind == 6 ? REP_AB : ((kind == 12 || kind == 14) ? REP_PREPOST : (kind == 13 ? REP_FFT : ((kind == 3 || kind == 8 || kind == 11) ? REP_RN : 1))));
                if (rep >= nrep) continue;
            }
            FRESH_TID();
            if (kind == 1 || kind == 9) {
                const bool second = (kind == 9);
                EpiSwiglu E{Zb, DFF};
#ifndef SKIP_GU
                run_gemm<EpiSwiglu>(lds, H, (const bf16*)(ws + WS_W + (second ? WO_GU2 : WO_GU1)), second ? rows2 : rows1, 2 * DFF, D, G, E);
#endif
            } else if (kind == 2 || kind == 10 || kind == 4 || kind == 7) {
                const bf16* A; const bf16* Bt; int M, N, K; bf16* O; int ldc;
                if (kind == 2)       { A = Zb; Bt = (const bf16*)(ws + WS_W + WO_D1); M = rows1; N = D; K = DFF; O = Y; ldc = D; }
                else if (kind == 10) { A = Zb; Bt = (const bf16*)(ws + WS_W + WO_D2); M = rows2; N = D; K = DFF; O = Y; ldc = D; }
                else if (kind == 4)  { A = H; Bt = (const bf16*)(ws + WS_W + WO_IN); M = rows1; N = ZW; K = D; O = Zb; ldc = ZW; }
                else                 { A = H; Bt = (const bf16*)(ws + WS_W + WO_IN); M = 0; N = 0; K = D; O = Y; ldc = D; }
                if (kind == 7)       { A = H; Bt = (const bf16*)(ws + WS_W + WO_OUT); M = rows2; N = D; K = D; O = Y; ldc = D; }
                const bool ctx_split = (kind == 2 || kind == 10 || kind == 7) && M == MTOT;
                if (ctx_split) M = MLAT;
                const bool with_vt = (kind == 4) && even;
                static_assert(WS_H - (WS_W + WO_IN + (size_t)1024 * D * 2) == (size_t)51 * 256 * D * 2 && WS_H - (WS_W + WO_IN) == (size_t)55 * 256 * D * 2, "V^T units reach W_v / H through tile indices");
#ifndef SKIP_GB
                {
                    pg8::Gemm g{A, Bt, M, N, K, K};
                    UniOrder S; S.so.init(M, with_vt ? N - 512 : N, G, (int)blockIdx.x); S.KS = ctx_split ? K / 256 : 0; S.nvt = with_vt ? 2 * (M / 256) : 0;
                    EpiZV E{pg8::EpiBf16<0>{O, ldc, nullptr, 0, 0, 1.f},
                            with_vt ? pg8::EpiBf16<0>{VT, MTOT, nullptr, 0, 0, 1.f} : pg8::EpiBf16<0>{(bf16*)(ws + WS_VT), D, nullptr, D, (size_t)MCTX * D, 1.f}, with_vt ? 51 : -128};
                    pg8::gemm_phase<EpiZV, UniOrder, true, true>(lds, g, S, E);
                }
#endif
            } else if (kind == 3) {
                rownorm_phase(a, G, rows1, false, true, false, Y, 0.5f, modl + 2 * 1024, ng + 1 * D, modl + 3 * 1024, modl + 4 * 1024, ng + 2 * D, H, wave, lane, rep + 1 < REP_RN, rows1 == MTOT ? DFF / 256 : 0);
            } else if (kind == 8) {
                rownorm_phase(a, G, rows2, false, true, false, Y, 1.0f, modl + 5 * 1024, ng + 3 * D, modl + 6 * 1024, modl + 7 * 1024, ng + 4 * D, H, wave, lane, rep + 1 < REP_RN, rows2 == MTOT ? D / 256 : 0);
            } else if (kind == 11) {
                const float* modn = modl + 5 * NMODW; const float* ngn = ng + 6 * D;
                rownorm_phase(a, G, rows2, false, l < 3, l == 3, Y, 0.5f, modl + 8 * 1024, ng + 5 * D, modn + 0 * 1024, modn + 1 * 1024, ngn, H, wave, lane, rep + 1 < REP_RN, rows2 == MTOT ? DFF / 256 : 0);
                if (l < 3 && rep + 1 >= REP_RN) { __syncthreads(); convert_layer(a, l + 1, lds, G, wave, lane); }
            } else if (kind == 6) {
#ifndef SKIP_AB
                ab_core_phase(a, l, lds, G, tid, wave, lane);
#endif
            } else if (kind == 12) {
#ifndef SKIP_PRE
                hy_pre_phase(a, l, lds, G, tid);
#endif
            } else if (kind == 13) {
#ifndef SKIP_CTXH
                if (l == 1 && rep == 0) hy_ctx_phase(a, l, lds, G, tid);
#endif
#ifndef SKIP_FFT
                hy_fft_phase(a, l, lds, G, tid, rep + 1 < REP_FFT);
#endif
            } else if (kind == 14) {
#ifndef SKIP_POST
                hy_post_phase(a, l, lds, G, tid);
#endif
            }
            for (int q_ = 0; q_ < REP_SYNC; ++q_) GRID_BARRIER();
        }
    }
}

#undef ws
#undef H
#undef Y
#undef Zb
#undef VT
#undef MOD
#undef NG
extern "C" void kernel_launch(void* const* d_in, const int* in_sizes, int n_in, void* d_out, int out_size, void* d_ws, size_t ws_size, hipStream_t stream) {
    static int grid = 0;
    if (grid == 0) {
        if (n_in != 26 || ws_size < WS_END) { fprintf(stderr, "kernel_launch: unexpected n_in %d or ws_size %zu (< %zu)\n", n_in, ws_size, (size_t)WS_END); grid = -1; return; }
        int dev = 0, cus = 0, per_cu = 0;
        hipGetDevice(&dev); hipDeviceGetAttribute(&cus, hipDeviceAttributeMultiprocessorCount, dev);
        hipFuncSetAttribute((const void*)fwd_megakernel, hipFuncAttributeMaxDynamicSharedMemorySize, LDS_BYTES);
        hipOccupancyMaxActiveBlocksPerMultiprocessor(&per_cu, (const void*)fwd_megakernel, NTHREADS, LDS_BYTES);
        if (per_cu < 1) { fprintf(stderr, "kernel_launch: occupancy query says %d blocks per CU\n", per_cu); per_cu = 1; }
        (void)hipGetLastError();
        grid = cus; if (grid > 256) grid = 256;
    }
    if (grid < 0) return;
    Args a{};
    for (int i = 0; i < 26; ++i) a.in[i] = (const float*)d_in[i];
    a.out = (float*)d_out; a.ws = (unsigned char*)d_ws;
    void* args[] = {&a};
    if (hipMemsetAsync((char*)d_ws + WS_BAR, 0, BAR_BYTES, stream) != hipSuccess) { fprintf(stderr, "kernel_launch: memset of barrier words failed\n"); return; }
    hipError_t e = hipLaunchCooperativeKernel((const void*)fwd_megakernel, dim3(grid), dim3(NTHREADS), args, LDS_BYTES, stream);
    if (e != hipSuccess) fprintf(stderr, "cooperative launch failed: %s (grid %d)\n", hipGetErrorString(e), grid);
}
```

```cpp
#include <hip/hip_runtime.h>
#include <hip/hip_cooperative_groups.h>
#include <cstdio>
#include <cstdint>
namespace cg = cooperative_groups;
#ifndef REP_GEMM
#define REP_GEMM 1
#endif
#ifndef REP_AB
#define REP_AB 1
#endif
#ifndef REP_PREPOST
#define REP_PREPOST 1
#endif
#ifndef REP_PRO
#define REP_PRO 1
#endif
#ifndef REP_R0
#define REP_R0 1
#endif
#ifndef REP_MAX
#define REP_MAX 1
#endif
#ifndef REP_FFT
#define REP_FFT 1
#endif
#ifndef REP_SYNC
#define REP_SYNC 1
#endif
#ifndef REP_RN
#define REP_RN 1
#endif
namespace pg8 {
#define PG8_LAS __attribute__((address_space(3)))
typedef unsigned short bf16_t;
typedef short bf16x8 __attribute__((ext_vector_type(8)));
typedef float f32x4 __attribute__((ext_vector_type(4)));
typedef unsigned u32x4 __attribute__((ext_vector_type(4)));
constexpr int BM = 256, BK = 64, HALF = 128, HTB = HALF * BK * 2  , STAGE_BYTES = 8 * HTB, NXCD = 8, WGM = 8;

__host__ __device__ __forceinline__ int lds_byte(int r, int c) { const int st = (r >> 4) * 2 + (c >> 5), rr = r & 15, cc = c & 31, ob = rr * 64 + cc * 2; return st * 1024 + (ob ^ (((ob >> 9) & 1) << 5)); }
__host__ __device__ __forceinline__ void stage_rc(int b, int& R, int& C) { const int st = b / 1024, sb = b % 1024, swz = sb ^ (((sb >> 9) & 1) << 5); R = (st >> 1) * 16 + swz / 64; C = (st & 1) * 32 + (swz % 64) / 2; }
__host__ __device__ __forceinline__ int perm32(int rho) { const int n = rho >> 4, i = rho & 15; return 8 * (i >> 2) + 4 * n + (i & 3); }

struct Unit { int pm, pn, bn, ko, nt; };
struct Gemm { const bf16_t* A; const bf16_t* Bt; int M, N, K, ld; };

struct StaticOrder {
    int nM, nN, nwg, G, c;
    __host__ __device__ void init(int M, int N, int G_, int c_) { nM = M / BM; nN = N / BM; nwg = nM * nN; G = G_; c = c_; }
    __host__ __device__ bool next(int i, Unit& u) const {
        const long L = (long)i * G + c; if (L >= nwg) return false;
        int wgid = (int)L; { const int q = nwg / NXCD, r = nwg % NXCD, xcd = wgid % NXCD, off = wgid / NXCD; wgid = (xcd < r ? xcd * (q + 1) : r * (q + 1) + (xcd - r) * q) + off; }
        const int nig = WGM * nN, gid = wgid / nig, fm = gid * WGM, gsz = (nM - fm) < WGM ? (nM - fm) : WGM;
        u.pm = fm + ((wgid % nig) % gsz); u.pn = (wgid % nig) / gsz; u.bn = u.pn; u.ko = 0; u.nt = 0; return true;
    }
    __device__ __forceinline__ void a_ready(const Unit&) const {}
    __device__ __forceinline__ void done(const Unit&) const {}
};

__device__ __forceinline__ unsigned cvt_pk_bf16(float lo, float hi) { unsigned r; asm volatile("v_cvt_pk_bf16_f32 %0, %1, %2" : "=v"(r) : "v"(lo), "v"(hi)); return r; }
typedef float f32x2 __attribute__((ext_vector_type(2)));
__device__ __forceinline__ f32x2 gelu_pk(f32x2 v) {
    const f32x2 av = __builtin_elementwise_abs(v), d = av * 0.2316418882f + 1.0f;
    f32x2 t; t.x = __builtin_amdgcn_rcpf(d.x); t.y = __builtin_amdgcn_rcpf(d.y);
    f32x2 q = t * 0.5307027145f + (-0.7265760135f); q = q * t + 0.7107068705f; q = q * t + (-0.142248368f); q = q * t + 0.127414796f; q = q * t;
    const f32x2 s = (v * v) * (-0.72134752044f);
    f32x2 e; e.x = __builtin_amdgcn_exp2f(s.x); e.y = __builtin_amdgcn_exp2f(s.y);
    const f32x2 m = v * (q * e), r = v - m;
    f32x2 o; o.x = v.x < 0.f ? m.x : r.x; o.y = v.y < 0.f ? m.y : r.y; return o;
}

template <int ACT  > struct EpiBf16 {
    static constexpr bool PERM = true, AFTER_DRAIN = false; static_assert(ACT == 0 || ACT == 1, "EpiBf16: ACT is 0 (none) or 1 (gelu_pk)");
    bf16_t* O; int ldc; const float* bias; int split_cols; size_t split_stride; float scale0;
    __device__ __forceinline__ void operator()(const f32x4 (&acc)[2][2][4][2], const Unit& u, int wr, int wc, int fr, int fq) const {
        const int row0 = u.pm * BM + wr * 64 + fr; int colt = u.pn * BM; bf16_t* base = O;
        float sc = 1.f; if (split_cols) { const int t = colt / split_cols; base += (size_t)t * split_stride; colt -= t * split_cols; if (t == 0) sc = scale0; }
        const int col0 = colt + wc * 32 + 8 * fq, bcol0 = u.pn * BM + wc * 32 + 8 * fq;
        f32x4 bv[2][2];
#pragma unroll
        for (int bj = 0; bj < 2; ++bj)
#pragma unroll
            for (int n = 0; n < 2; ++n) bv[bj][n] = bias ? *(const f32x4*)(bias + bcol0 + bj * HALF + 4 * n) : (f32x4){0.f, 0.f, 0.f, 0.f};
#pragma unroll
        for (int ai = 0; ai < 2; ++ai)
#pragma unroll
            for (int m = 0; m < 4; ++m) { bf16_t* rowp = base + (size_t)(row0 + ai * HALF + m * 16) * ldc + col0;
#pragma unroll
                for (int bj = 0; bj < 2; ++bj) { f32x4 v0 = acc[ai][bj][m][0] + bv[bj][0], v1 = acc[ai][bj][m][1] + bv[bj][1];
                    if (ACT == 1) { f32x2 a = gelu_pk((f32x2){v0[0], v0[1]}), b = gelu_pk((f32x2){v0[2], v0[3]}), c = gelu_pk((f32x2){v1[0], v1[1]}), d = gelu_pk((f32x2){v1[2], v1[3]});
                        v0 = (f32x4){a.x, a.y, b.x, b.y}; v1 = (f32x4){c.x, c.y, d.x, d.y}; }
                    v0 = v0 * sc; v1 = v1 * sc; u32x4 w; w.x = cvt_pk_bf16(v0[0], v0[1]); w.y = cvt_pk_bf16(v0[2], v0[3]); w.z = cvt_pk_bf16(v1[0], v1[1]); w.w = cvt_pk_bf16(v1[2], v1[3]);
                    *(u32x4*)(rowp + bj * HALF) = w; } }
    }
};
template <class Epi, class Sched, bool ALIGN_EPI = false, bool SP2 = false>
__device__ __forceinline__ void gemm_phase(PG8_LAS unsigned char* lds, const Gemm g, const Sched& S, const Epi& E) {
    int tid_l = threadIdx.x; asm volatile("" : "+v"(tid_l));
    const int tid = tid_l, wid = __builtin_amdgcn_readfirstlane(tid >> 6), lane = tid & 63, wr = wid >> 2, wc = wid & 3, fr = lane & 15, fq = lane >> 4;
    const int K = g.ld, nt = g.K / BK;
    unsigned voffA[2], voffB[2];
#pragma unroll
    for (int i = 0; i < 2; ++i) { int R, C; stage_rc(tid * 16 + i * 8192, R, C); const int Rb = Epi::PERM ? ((R & ~31) + perm32(R & 31)) : R;
        voffA[i] = (unsigned)(R * K + C) * 2u; voffB[i] = (unsigned)(Rb * K + C) * 2u; }
    const size_t kstep = (size_t)(BK * 2);
    const size_t hstep = (size_t)HALF * K * 2;
    const size_t tstep = 2 * hstep;
    const unsigned ldsw = (unsigned)wid * 1024u;
    const int aoff = lds_byte(wr * 64 + fr, fq * 8), boff = lds_byte(wc * 32 + fr, fq * 8);
#define PG8_SA(b, h) (((b) * 2 + (h)) * HTB)
#define PG8_SB(b, h) ((4 + (b) * 2 + (h)) * HTB)
#define PG8_STAGE(bufoff, gbase, voff) do { _Pragma("unroll") for (int _i = 0; _i < 2; ++_i) \
        __builtin_amdgcn_global_load_lds((const unsigned*)((const char*)(gbase) + (voff)[_i]), (PG8_LAS unsigned*)(lds + (bufoff) + ldsw + _i * 8192), 16, 0, 0); } while (0)
#define PG8_LDA(dst, b, h) do { _Pragma("unroll") for (int m = 0; m < 4; ++m) _Pragma("unroll") for (int k = 0; k < 2; ++k) dst[m][k] = *(const PG8_LAS bf16x8*)(lds + PG8_SA(b, h) + aoff + m * 2048 + k * 1024); } while (0)
#define PG8_LDB(dst, b, h) do { _Pragma("unroll") for (int n = 0; n < 2; ++n) _Pragma("unroll") for (int k = 0; k < 2; ++k) dst[n][k] = *(const PG8_LAS bf16x8*)(lds + PG8_SB(b, h) + boff + n * 2048 + k * 1024); } while (0)
#define PG8_MMA(ai, bj, At, Bt) do { __builtin_amdgcn_s_setprio(1); _Pragma("unroll") for (int m = 0; m < 4; ++m) _Pragma("unroll") for (int n = 0; n < 2; ++n) _Pragma("unroll") for (int k = 0; k < 2; ++k) \
        acc[ai][bj][m][n] = __builtin_amdgcn_mfma_f32_16x16x32_bf16(Bt[n][k], At[m][k], acc[ai][bj][m][n], 0, 0, 0); __builtin_amdgcn_s_setprio(0); } while (0)
#define PG8_WAIT_V(n) asm volatile("s_waitcnt vmcnt(" #n ")" ::: "memory")
#define PG8_WAIT_L(n) asm volatile("s_waitcnt lgkmcnt(" #n ")" ::: "memory")
#define PG8_BAR __builtin_amdgcn_s_barrier()
#define PG8_SCHED __builtin_amdgcn_sched_barrier(0)
    Unit cur, nxt; int ui = 0;
    if (!S.next(0, cur)) return;
    f32x4 acc[2][2][4][2];
#pragma unroll
    for (int a = 0; a < 2; ++a)
#pragma unroll
        for (int b = 0; b < 2; ++b)
#pragma unroll
            for (int m = 0; m < 4; ++m)
#pragma unroll
                for (int n = 0; n < 2; ++n) acc[a][b][m][n] = (f32x4){0.f, 0.f, 0.f, 0.f};
    bf16x8 At[4][2], B0[2][2], B1[2][2];
    const char* cA = (const char*)g.A + (size_t)cur.pm * tstep + (size_t)cur.ko * 2; const char* cB = (const char*)g.Bt + (size_t)cur.bn * tstep + (size_t)cur.ko * 2;
    S.a_ready(cur);
    if constexpr (SP2) {
        PG8_STAGE(PG8_SB(0, 0), cB, voffB); PG8_STAGE(PG8_SB(0, 1), cB + hstep, voffB); PG8_STAGE(PG8_SA(0, 0), cA, voffA); PG8_STAGE(PG8_SA(0, 1), cA + hstep, voffA);
        if (wr == 1) PG8_BAR;
        PG8_WAIT_V(2); PG8_BAR;
        PG8_STAGE(PG8_SB(1, 0), cB + kstep, voffB); PG8_STAGE(PG8_SA(1, 0), cA + kstep, voffA); PG8_STAGE(PG8_SB(1, 1), cB + hstep + kstep, voffB);
        PG8_WAIT_V(6); PG8_BAR;
    } else {
        PG8_STAGE(PG8_SB(0, 0), cB, voffB); PG8_STAGE(PG8_SA(0, 0), cA, voffA); PG8_STAGE(PG8_SB(0, 1), cB + hstep, voffB); PG8_STAGE(PG8_SA(0, 1), cA + hstep, voffA);
        if (wr == 1) PG8_BAR;
        PG8_WAIT_V(4); PG8_BAR;
        PG8_STAGE(PG8_SB(1, 0), cB + kstep, voffB); PG8_STAGE(PG8_SA(1, 0), cA + kstep, voffA); PG8_STAGE(PG8_SB(1, 1), cB + hstep + kstep, voffB);
        PG8_WAIT_V(6); PG8_BAR;
    }
    for (;;) {
        const bool has_next = S.next(ui + 1, nxt);
        const char* nA = has_next ? (const char*)g.A + (size_t)nxt.pm * tstep + (size_t)nxt.ko * 2 : cA; const char* nB = has_next ? (const char*)g.Bt + (size_t)nxt.bn * tstep + (size_t)nxt.ko * 2 : cB;
        const int ntc = cur.nt ? cur.nt : nt;
        for (int t = 0; t < ntc; t += 2) {
            const bool last = (t == ntc - 2);
            const char* a1 = cA + (size_t)(t + 1) * kstep;
            const char* a2 = last ? nA : cA + (size_t)(t + 2) * kstep; const char* b2 = last ? nB : cB + (size_t)(t + 2) * kstep;
            const char* a3 = a2 + kstep; const char* b3 = b2 + kstep;
            if (last && has_next) S.a_ready(nxt);
            if constexpr (SP2) {
            PG8_LDB(B0, 0, 0); PG8_LDB(B1, 0, 1); PG8_SCHED; PG8_LDA(At, 0, 0); PG8_STAGE(PG8_SA(1, 1), a1 + hstep, voffA);
            PG8_WAIT_V(8); PG8_WAIT_L(0); PG8_BAR; PG8_MMA(0, 0, At, B0); PG8_MMA(0, 1, At, B1); PG8_BAR; PG8_SCHED;
            PG8_LDA(At, 0, 1); PG8_STAGE(PG8_SB(0, 0), b2, voffB); PG8_STAGE(PG8_SB(0, 1), b2 + hstep, voffB); PG8_STAGE(PG8_SA(0, 0), a2, voffA);
            PG8_WAIT_V(8); PG8_WAIT_L(0); PG8_BAR; PG8_MMA(1, 0, At, B0); PG8_MMA(1, 1, At, B1); PG8_BAR; PG8_SCHED;
            PG8_LDB(B0, 1, 0); PG8_LDB(B1, 1, 1); PG8_SCHED; PG8_LDA(At, 1, 0); PG8_STAGE(PG8_SA(0, 1), a2 + hstep, voffA);
            PG8_WAIT_V(8); PG8_WAIT_L(0); PG8_BAR; PG8_MMA(0, 0, At, B0); PG8_MMA(0, 1, At, B1); PG8_BAR; PG8_SCHED;
            PG8_LDA(At, 1, 1); PG8_STAGE(PG8_SB(1, 0), b3, voffB); PG8_STAGE(PG8_SB(1, 1), b3 + hstep, voffB); PG8_STAGE(PG8_SA(1, 0), a3, voffA);
            PG8_WAIT_V(8); PG8_WAIT_L(0); PG8_BAR; PG8_MMA(1, 0, At, B0); PG8_MMA(1, 1, At, B1); PG8_BAR; PG8_SCHED;
            } else {
            PG8_LDB(B0, 0, 0); PG8_SCHED; PG8_LDA(At, 0, 0); PG8_STAGE(PG8_SA(1, 1), a1 + hstep, voffA);
            PG8_WAIT_L(8); PG8_BAR; PG8_WAIT_L(0); PG8_MMA(0, 0, At, B0); PG8_BAR; PG8_SCHED;
            PG8_LDB(B1, 0, 1); PG8_STAGE(PG8_SB(0, 0), b2, voffB);
            PG8_BAR; PG8_WAIT_L(0); PG8_MMA(0, 1, At, B1); PG8_BAR;
            PG8_LDA(At, 0, 1); PG8_STAGE(PG8_SA(0, 0), a2, voffA);
            PG8_BAR; PG8_WAIT_L(0); PG8_MMA(1, 0, At, B0); PG8_BAR; PG8_SCHED;
            PG8_STAGE(PG8_SB(0, 1), b2 + hstep, voffB);
            PG8_WAIT_V(6); PG8_BAR; PG8_MMA(1, 1, At, B1); PG8_BAR;
            PG8_LDB(B0, 1, 0); PG8_SCHED; PG8_LDA(At, 1, 0); PG8_STAGE(PG8_SA(0, 1), a2 + hstep, voffA);
            PG8_WAIT_L(8); PG8_BAR; PG8_WAIT_L(0); PG8_MMA(0, 0, At, B0); PG8_BAR; PG8_SCHED;
            PG8_LDB(B1, 1, 1); PG8_STAGE(PG8_SB(1, 0), b3, voffB);
            PG8_BAR; PG8_WAIT_L(0); PG8_MMA(0, 1, At, B1); PG8_BAR;
            PG8_LDA(At, 1, 1); PG8_STAGE(PG8_SA(1, 0), a3, voffA);
            PG8_BAR; PG8_WAIT_L(0); PG8_MMA(1, 0, At, B0); PG8_BAR; PG8_SCHED;
            PG8_STAGE(PG8_SB(1, 1), b3 + hstep, voffB);
            PG8_WAIT_V(6); PG8_BAR; PG8_MMA(1, 1, At, B1); PG8_BAR;
            }
        }
        if constexpr (ALIGN_EPI) { if (wr == 0) PG8_BAR; }
        if constexpr (!Epi::AFTER_DRAIN) { E(acc, cur, wr, wc, fr, fq); S.done(cur); }
        if (!has_next) break;
#pragma unroll
        for (int a = 0; a < 2; ++a)
#pragma unroll
            for (int b = 0; b < 2; ++b)
#pragma unroll
                for (int m = 0; m < 4; ++m)
#pragma unroll
                    for (int n = 0; n < 2; ++n) acc[a][b][m][n] = (f32x4){0.f, 0.f, 0.f, 0.f};
        cur = nxt; cA = nA; cB = nB; ++ui;
        if constexpr (ALIGN_EPI) { if (wr == 1) PG8_BAR; }
    }
    PG8_WAIT_V(0);
    if constexpr (!ALIGN_EPI) { if (wr == 0) PG8_BAR; }
    PG8_BAR;
    if constexpr (Epi::AFTER_DRAIN) { E.fused(acc, cur, wr, wc, fr, fq, lds, wid, lane); S.done(cur); }
#undef PG8_SA
#undef PG8_SB
#undef PG8_STAGE
#undef PG8_LDA
#undef PG8_LDB
#undef PG8_MMA
#undef PG8_WAIT_V
#undef PG8_WAIT_L
#undef PG8_BAR
#undef PG8_SCHED
}
}

#define LAS __attribute__((address_space(3)))
typedef unsigned short bf16;
typedef unsigned u32x4 __attribute__((ext_vector_type(4)));
typedef unsigned u32x2 __attribute__((ext_vector_type(2)));
typedef float f32x4 __attribute__((ext_vector_type(4)));
typedef short bf16x8 __attribute__((ext_vector_type(8)));

constexpr int D = 1024, NB = 4, SEQ = 8192, CTXL = 256, DFF = 2816, NMODW = 9 * 1024;
constexpr int MLAT = NB * SEQ, MCTX = NB * CTXL, MTOT = MLAT + MCTX, ZW = 3072;
constexpr int NTHREADS = 512, NWAVES = 8;
constexpr float RMS_EPS = 1e-6f;
constexpr int FFTN = 16384;
constexpr int LDS_BYTES = 140288;

constexpr size_t MiB = 1u << 20;
constexpr size_t WS_BAR = 50 * MiB, BAR_BYTES = 16384;
constexpr size_t WS_XC = 0, WS_MOD = 4 * MiB, WS_TW = 5 * MiB, WS_FTC = 6 * MiB, WS_W = 8 * MiB;
constexpr size_t W_GU = (size_t)2 * DFF * D * 2, W_DN = (size_t)D * DFF * 2, W_IN = (size_t)ZW * D * 2, W_OUT = (size_t)D * D * 2;
constexpr size_t WO_GU1 = 0, WO_D1 = W_GU, WO_IN = WO_D1 + W_DN, WO_OUT = WO_IN + W_IN, WO_GU2 = WO_OUT + W_OUT, WO_D2 = WO_GU2 + W_GU, W_TOTAL = WO_D2 + W_DN;
constexpr size_t WS_H = 52 * MiB, WS_Y = 118 * MiB, WS_Z = 184 * MiB, WS_VT = 382 * MiB, WS_XB = 415 * MiB, WS_KFS = 543 * MiB, WS_END = 575 * MiB;
static_assert(WS_W + W_TOTAL <= WS_BAR && WS_BAR + BAR_BYTES <= WS_H, "weights region");
static_assert(WS_H + (size_t)MTOT * D * 2 <= WS_Y && WS_Y + (size_t)MTOT * D * 2 <= WS_Z && WS_Z + (size_t)MTOT * ZW * 2 <= WS_VT, "ws map");
static_assert(WS_VT + (size_t)512 * MTOT * 2 <= WS_XB && WS_XB + (size_t)MTOT * D * 2 <= WS_KFS && WS_KFS + (size_t)256 * FFTN * 8 <= WS_END && (size_t)2 * 2 * 1024 * 8192 * 4 <= (size_t)MLAT * D * 4, "ws map 2");

struct Args { const float* in[26]; float* out; unsigned char* ws; };
#define CAS __attribute__((address_space(4)))
typedef CAS const unsigned char* kptr_t;
__device__ __forceinline__ kptr_t karg_base() { kptr_t kp = (kptr_t)__builtin_amdgcn_kernarg_segment_ptr(); asm volatile("" : "+s"(kp)); return kp; }
#define KIN(i) (*(const float* CAS const*)(karg_base() + 8 * (i)))
#define KOUT() (*(float* CAS const*)(karg_base() + 208))
#define KWS() (*(unsigned char* CAS const*)(karg_base() + 216))

__device__ __forceinline__ float bf_lo(unsigned v) { return __uint_as_float(v << 16); }
__device__ __forceinline__ float bf_hi(unsigned v) { return __uint_as_float(v & 0xffff0000u); }
__device__ __forceinline__ float bf1(unsigned short v) { return __uint_as_float((unsigned)v << 16); }
__device__ __forceinline__ unsigned pk2(float lo, float hi) { return pg8::cvt_pk_bf16(lo, hi); }
__device__ __forceinline__ unsigned short f2bf(float f) { return (unsigned short)(pg8::cvt_pk_bf16(f, 0.f) & 0xffffu); }
#define UNPACK8(v, f) do { f[0] = bf_lo(v.x); f[1] = bf_hi(v.x); f[2] = bf_lo(v.y); f[3] = bf_hi(v.y); f[4] = bf_lo(v.z); f[5] = bf_hi(v.z); f[6] = bf_lo(v.w); f[7] = bf_hi(v.w); } while (0)
__device__ __forceinline__ float lane_xor_f(float v, int mask, int lane) { return __builtin_bit_cast(float, __builtin_amdgcn_ds_bpermute((lane ^ mask) << 2, __builtin_bit_cast(int, v))); }
__device__ __forceinline__ float lane_get_f(float v, int src) { return __builtin_bit_cast(float, __builtin_amdgcn_ds_bpermute(src << 2, __builtin_bit_cast(int, v))); }
__device__ __forceinline__ float wave_sum(float v, int lane) {
#pragma unroll
    for (int o = 1; o < 64; o <<= 1) v += lane_xor_f(v, o, lane);
    return v;
}
#define LDS_WAIT() asm volatile("s_waitcnt lgkmcnt(0)" ::: "memory")
#define XB_TMO      128
#define XB_XCNT(j)  (256  + 64 * (j))
#define XB_XSUB(j)  (1280 + 64 * (j))
#define XB_XGEN(j)  (2304 + 64 * (j))
#define XB_TOP      3328
#define XB_TOPGEN   3392
#define XCD_BAR_WORDS 3456
static_assert(XCD_BAR_WORDS * 4 <= BAR_BYTES, "barrier words");
#define XB_SPIN_CAP (1u << 18)

__device__ __forceinline__ unsigned xb_ld(unsigned* p)              { return __hip_atomic_load(p, __ATOMIC_RELAXED, __HIP_MEMORY_SCOPE_AGENT); }
__device__ __forceinline__ unsigned xb_add(unsigned* p, unsigned v) { return __hip_atomic_fetch_add(p, v, __ATOMIC_RELAXED, __HIP_MEMORY_SCOPE_AGENT); }
__device__ __forceinline__ unsigned xb_xcc_id() { return (unsigned)__builtin_amdgcn_s_getreg((3 << 11) | 20) & 0xFu; }
#define XB_SPIN(cond, bar) do { unsigned _sp = 0; while (cond) { __builtin_amdgcn_s_sleep(1); \
    if ((++_sp & 255u) == 0u) { if (xb_ld(&(bar)[XB_TMO])) break; if (_sp > XB_SPIN_CAP) { atomicAdd(&(bar)[XB_TMO], 1u); break; } } } } while (0)

struct XcdBarrier {
    unsigned* bar; unsigned x;
    volatile LAS unsigned* st;
};

__device__ __forceinline__ XcdBarrier xcd_barrier_post(unsigned* bar, volatile LAS unsigned* st) {
    XcdBarrier b; b.bar = bar; b.x = xb_xcc_id(); b.st = st;
    if (threadIdx.x == 0) (void)xb_add(&bar[XB_XCNT(b.x)], 1u);
    return b;
}
__device__ __forceinline__ void xcd_barrier_complete(unsigned* bar, unsigned x, unsigned& nloc, unsigned& nx) {
    const unsigned G = gridDim.x * gridDim.y * gridDim.z;
    unsigned sum, cnt, mine, sp = 0u;
    for (;;) {
        sum = 0u; cnt = 0u; mine = 0u;
#pragma unroll
        for (unsigned j = 0; j < 16; ++j) { const unsigned c = xb_ld(&bar[XB_XCNT(j)]); sum += c; cnt += (c > 0u) ? 1u : 0u; mine = (j == x) ? c : mine; }
        if (sum == G) break;
        __builtin_amdgcn_s_sleep(1);
        if ((++sp & 255u) == 0u) { if (xb_ld(&bar[XB_TMO])) break; if (sp > XB_SPIN_CAP) { atomicAdd(&bar[XB_TMO], 1u); break; } }
    }
    nloc = mine > 0u ? mine : 1u; nx = cnt > 0u ? cnt : 1u;
}

__device__ __forceinline__ void xcd_barrier(const XcdBarrier& b) {
    asm volatile("s_waitcnt vmcnt(0)" ::: "memory");
    __syncthreads();
    if (threadIdx.x == 0) {
        unsigned* bar = b.bar;
        __builtin_amdgcn_s_waitcnt(0);
        unsigned nloc = b.st[0], nx = b.st[1];
        if (nloc == 0u) { xcd_barrier_complete(bar, b.x, nloc, nx); b.st[0] = nloc; b.st[1] = nx; }
        const unsigned old = xb_add(&bar[XB_XSUB(b.x)], 1u);
        const unsigned gen = old / nloc;
        if (old + 1u == (gen + 1u) * nloc) {
            __builtin_amdgcn_fence(__ATOMIC_RELEASE, "agent");
            asm volatile("s_waitcnt vmcnt(0)" ::: "memory");
            const unsigned og = xb_add(&bar[XB_TOP], 1u);
            const unsigned tg = og / nx;
            if (og + 1u == (tg + 1u) * nx) xb_add(&bar[XB_TOPGEN], 1u);
            else XB_SPIN(xb_ld(&bar[XB_TOPGEN]) == tg, bar);
            __builtin_amdgcn_fence(__ATOMIC_ACQUIRE, "agent");
            xb_add(&bar[XB_XGEN(b.x)], 1u);
            asm volatile("s_waitcnt vmcnt(0)" ::: "memory");
        } else {
            XB_SPIN(xb_ld(&bar[XB_XGEN(b.x)]) == gen, bar);
            __builtin_amdgcn_fence(__ATOMIC_ACQUIRE, "agent");
            asm volatile("s_waitcnt vmcnt(0)" ::: "memory");
        }
    }
    __syncthreads();
}


struct EpiSwiglu {
    static constexpr bool PERM = true, AFTER_DRAIN = false;
    bf16* O; int ldc;
    __device__ __forceinline__ void operator()(const pg8::f32x4 (&acc)[2][2][4][2], const pg8::Unit& u, int wr, int wc, int fr, int fq) const {
        const int row0 = u.pm * 256 + wr * 64 + fr, col0 = u.pn * 128 + wc * 32 + 8 * fq;
#pragma unroll
        for (int ai = 0; ai < 2; ++ai)
#pragma unroll
            for (int m = 0; m < 4; ++m) {
                bf16* rowp = O + (size_t)(row0 + ai * 128 + m * 16) * ldc + col0;
                float v[8];
#pragma unroll
                for (int n = 0; n < 2; ++n)
#pragma unroll
                    for (int e = 0; e < 4; ++e) { const float g = acc[ai][0][m][n][e], up = acc[ai][1][m][n][e]; v[n * 4 + e] = g * __builtin_amdgcn_rcpf(1.f + __builtin_amdgcn_exp2f(g * -1.4426950408889634f)) * up; }
                u32x4 w; w.x = pk2(v[0], v[1]); w.y = pk2(v[2], v[3]); w.z = pk2(v[4], v[5]); w.w = pk2(v[6], v[7]);
                *(u32x4*)rowp = w;
            }
    }
};

struct UniOrder {
    pg8::StaticOrder so; int KS; int nvt;
    __device__ __forceinline__ bool next(int i, pg8::Unit& u) const {
        if (so.next(i, u)) { if (nvt && u.pn >= 4) { u.pn += 2; u.bn = u.pn; } return true; }
        const int v = i * so.G + so.c - so.nwg;
        if (nvt) {
            if (v >= nvt) return false;
            const int tt = v >> 1, vt = v & 1; u.pm = vt - 51; u.bn = 55 + tt; u.pn = 1000 + tt; u.ko = 0; u.nt = 0; return true;
        }
        if (KS) {
            if (v >= 16 * KS) return false;
            const int ks = v % KS, tile = v / KS; u.pm = 128 + (tile >> 2); u.bn = tile & 3; u.pn = 1000 + ks * 4 + (tile & 3); u.ko = ks * 256; u.nt = 4; return true;
        }
        return false;
    }
    __device__ __forceinline__ void a_ready(const pg8::Unit&) const {}
    __device__ __forceinline__ void done(const pg8::Unit&) const {}
};
struct EpiZV {
    static constexpr bool PERM = true, AFTER_DRAIN = false;
    pg8::EpiBf16<0> ez, ev; int pm_adj;
    __device__ __forceinline__ void operator()(const pg8::f32x4 (&acc)[2][2][4][2], const pg8::Unit& u, int wr, int wc, int fr, int fq) const {
        if (u.pn >= 1000) { pg8::Unit u2 = u; u2.pm = u.pm + pm_adj; u2.pn = u.pn - 1000; ev(acc, u2, wr, wc, fr, fq); } else ez(acc, u, wr, wc, fr, fq);
    }
};
template <class Epi>
__device__ __forceinline__ void run_gemm(LAS unsigned char* lds, const bf16* A, const bf16* Bt, int M, int N, int K, int G, const Epi& E) {
    pg8::Gemm g{A, Bt, M, N, K, K}; UniOrder S; S.so.init(M, N, G, (int)blockIdx.x); S.KS = 0; S.nvt = 0;
    pg8::gemm_phase<Epi, UniOrder, true, true>(lds, g, S, E);
}

constexpr int TR_SCR_BYTES = 64 * 65 * 4;
__device__ __forceinline__ void transpose_item(const float* __restrict__ W, int K, int N, bf16* WT, int il, LAS float* scr, int item, int lane) {
    const int nblk = N / 64, kb = item / nblk, nb = item % nblk, k0 = 64 * kb, n0 = 64 * nb;
    f32x4 v[16];
#pragma unroll
    for (int i = 0; i < 16; ++i) v[i] = *(const f32x4*)(W + (size_t)(k0 + 4 * i + (lane >> 4)) * N + n0 + (lane & 15) * 4);
#pragma unroll
    for (int i = 0; i < 16; ++i) { LAS float* d = scr + (4 * i + (lane >> 4)) * 65 + (lane & 15) * 4; d[0] = v[i].x; d[1] = v[i].y; d[2] = v[i].z; d[3] = v[i].w; }
    LDS_WAIT(); asm volatile("" ::: "memory");
    const int rbase = il ? ((n0 >> 7) * 256 + (n0 & 127) + (il == 2 ? 128 : 0)) : n0;
    const int c = lane & 7;
#pragma unroll
    for (int j = 0; j < 8; ++j) { const int n = (lane >> 3) + 8 * j; const LAS float* s = scr + (8 * c) * 65 + n;
        u32x4 o; o.x = pk2(s[0 * 65], s[1 * 65]); o.y = pk2(s[2 * 65], s[3 * 65]); o.z = pk2(s[4 * 65], s[5 * 65]); o.w = pk2(s[6 * 65], s[7 * 65]);
        *(u32x4*)(WT + (size_t)(rbase + n) * K + k0 + 8 * c) = o; }
    LDS_WAIT(); asm volatile("" ::: "memory");
}
__device__ __forceinline__ void convert_layer(const Args& a, int l, LAS unsigned char* lds, int G, int wave, int lane, int skip_blocks = 0) {
    LAS float* scr = (LAS float*)(lds + wave * TR_SCR_BYTES);
    const int j = l >> 1; const bool even = !(l & 1);
    unsigned char* wb = KWS() + WS_W;
    const float* g1 = KIN(7) + (size_t)(l * 2) * D * DFF; const float* u1 = KIN(8) + (size_t)(l * 2) * D * DFF; const float* d1 = KIN(9) + (size_t)(l * 2) * DFF * D;
    const float* g2 = g1 + (size_t)D * DFF; const float* u2 = u1 + (size_t)D * DFF; const float* d2 = d1 + (size_t)DFF * D;
    const float* win = even ? KIN(10) + (size_t)j * D * ZW : KIN(14) + (size_t)j * D * ZW;
    const float* wout = even ? KIN(13) + (size_t)j * D * D : KIN(25) + (size_t)j * D * D;
    constexpr int I_G = (D / 64) * (DFF / 64), I_D = (DFF / 64) * (D / 64), I_IN = (D / 64) * (ZW / 64), I_OUT = (D / 64) * (D / 64);
    constexpr int NITEMS = 4 * I_G + 2 * I_D + I_IN + I_OUT;
    if ((int)blockIdx.x < skip_blocks) return;
    const int gw = ((int)blockIdx.x - skip_blocks) * NWAVES + wave, NGW = (G - skip_blocks) * NWAVES;
    for (int it = gw; it < NITEMS; it += NGW) {
        int r = it;
        if (r < I_G) { transpose_item(g1, D, DFF, (bf16*)(wb + WO_GU1), 1, scr, r, lane); continue; } r -= I_G;
        if (r < I_G) { transpose_item(u1, D, DFF, (bf16*)(wb + WO_GU1), 2, scr, r, lane); continue; } r -= I_G;
        if (r < I_D) { transpose_item(d1, DFF, D, (bf16*)(wb + WO_D1), 0, scr, r, lane); continue; } r -= I_D;
        if (r < I_IN) { transpose_item(win, D, ZW, (bf16*)(wb + WO_IN), 0, scr, r, lane); continue; } r -= I_IN;
        if (r < I_OUT) { transpose_item(wout, D, D, (bf16*)(wb + WO_OUT), 0, scr, r, lane); continue; } r -= I_OUT;
        if (r < I_G) { transpose_item(g2, D, DFF, (bf16*)(wb + WO_GU2), 1, scr, r, lane); continue; } r -= I_G;
        if (r < I_G) { transpose_item(u2, D, DFF, (bf16*)(wb + WO_GU2), 2, scr, r, lane); continue; } r -= I_G;
        transpose_item(d2, DFF, D, (bf16*)(wb + WO_D2), 0, scr, r, lane);
    }
}

__device__ __forceinline__ void mod_phase(const Args& a, LAS unsigned char* lds, int G, int tid, int wave, int lane) {
    LAS float* sS = (LAS float*)lds;
    LAS float* red = (LAS float*)(lds + 20480);
    float* MOD = (float*)(KWS() + WS_MOD);
    for (int idx = tid; idx < 5 * 1024; idx += NTHREADS) { const int r = idx >> 10, k = idx & 1023; const float v = r < 4 ? KIN(1)[r * 1024 + k] : KIN(3)[k]; sS[idx] = v / (1.f + expf(-v)); }
    __syncthreads();
    for (int item = blockIdx.x; item < 4 * 144; item += G) {
        const int l = item / 144, ch = item % 144, n = ch * 64 + lane;
        const float* wp = KIN(4) + (size_t)l * D * NMODW + (size_t)(wave * 128) * NMODW + n;
        float acc[5] = {0.f, 0.f, 0.f, 0.f, 0.f};
#pragma unroll 32
        for (int kk = 0; kk < 128; ++kk) { const float wv = wp[(size_t)kk * NMODW];
#pragma unroll
            for (int r = 0; r < 5; ++r) acc[r] += sS[r * 1024 + wave * 128 + kk] * wv; }
#pragma unroll
        for (int r = 0; r < 5; ++r) red[(wave * 5 + r) * 64 + lane] = acc[r];
        __syncthreads();
        if (tid < 320) { const int r = tid >> 6, nn = tid & 63; float s = KIN(5)[l * NMODW + ch * 64 + nn];
#pragma unroll
            for (int w = 0; w < 8; ++w) s += red[(w * 5 + r) * 64 + nn];
            MOD[(size_t)(l * 5 + r) * NMODW + ch * 64 + nn] = s; }
        __syncthreads();
    }
}

__device__ __forceinline__ void hy_filter_item(const Args& a, int hl, int n, int t0, float* FT, LAS unsigned char* lds, int tid, int wave, int lane) {
    LAS float* bufA = (LAS float*)lds;
    LAS float* bufB = (LAS float*)(lds + 16384);
    typedef CAS const float* cfp;
    const cfp w1 = (cfp)(KIN(16) + hl * 33 * 64); const cfp b1 = (cfp)(KIN(17) + hl * 64); const cfp w2 = (cfp)(KIN(18) + hl * 4096); const cfp b2 = (cfp)(KIN(19) + hl * 64);
    const cfp w3 = (cfp)(KIN(20) + hl * 4096); const cfp b3 = (cfp)(KIN(21) + hl * 64); const cfp w4 = (cfp)(KIN(22) + (size_t)hl * 64 * 2048); const cfp fr = (cfp)(KIN(23) + hl * 64);
    const int t = t0 + lane;
    const float tt = (float)t / (float)(n - 1);
    const float wv = 6.283185307179586f * (float)t / (float)n;
    for (int f = wave; f < 33; f += NWAVES) {
        float v;
        if (f == 0) v = tt;
        else { const int k = (f - 1) & 15; const float band = 1e-4f + (float)k * ((15.0f - 1e-4f) / 15.0f); const float ang = band * wv; v = (f <= 16) ? cosf(ang) : -sinf(ang); }
        bufB[f * 64 + lane] = v;
    }
    __syncthreads();
    const int j0 = wave * 8;
    {
        float in[33];
#pragma unroll
        for (int i = 0; i < 33; ++i) in[i] = bufB[i * 64 + lane];
#pragma unroll
        for (int jj = 0; jj < 8; ++jj) { float acc = b1[j0 + jj];
#pragma unroll
            for (int i = 0; i < 33; ++i) { acc += in[i] * w1[i * 64 + j0 + jj]; }
            bufA[(j0 + jj) * 64 + lane] = sinf(fr[j0 + jj] * acc); }
    }
    __syncthreads();
    {
        float in[64];
#pragma unroll
        for (int i = 0; i < 64; ++i) in[i] = bufA[i * 64 + lane];
#pragma unroll
        for (int jj = 0; jj < 8; ++jj) { float acc = b2[j0 + jj];
#pragma unroll
            for (int i = 0; i < 64; ++i) { acc += in[i] * w2[i * 64 + j0 + jj]; }
            bufB[(j0 + jj) * 64 + lane] = sinf(fr[j0 + jj] * acc); }
    }
    __syncthreads();
    {
        float in[64];
#pragma unroll
        for (int i = 0; i < 64; ++i) in[i] = bufB[i * 64 + lane];
#pragma unroll
        for (int jj = 0; jj < 8; ++jj) { float acc = b3[j0 + jj];
#pragma unroll
            for (int i = 0; i < 64; ++i) { acc += in[i] * w3[i * 64 + j0 + jj]; }
            bufA[(j0 + jj) * 64 + lane] = sinf(fr[j0 + jj] * acc); }
    }
    __syncthreads();
    {
        float in[64];
#pragma unroll
        for (int i = 0; i < 64; ++i) in[i] = bufA[i * 64 + lane];
        const float dmin = -3.0701134573253943f, dmax = -15.350567286626972f;
        for (int nb = 0; nb < 256; nb += 8) {
            const int n0 = wave * 256 + nb;
            float acc[8] = {0.f, 0.f, 0.f, 0.f, 0.f, 0.f, 0.f, 0.f};
#pragma unroll
            for (int i = 0; i < 64; ++i) {
#pragma unroll
                for (int e = 0; e < 8; ++e) acc[e] += in[i] * w4[i * 2048 + n0 + e]; }
#pragma unroll
            for (int e = 0; e < 8; ++e) { const int nn = n0 + e, c = nn & 1023; const float dl = dmin + (float)c * ((dmax - dmin) / 1023.0f);
                FT[(size_t)nn * n + t] = acc[e] * expf(-tt * fabsf(dl)); }
        }
    }
    __syncthreads();
}

__device__ __forceinline__ void prologue(const Args& a, LAS unsigned char* lds, int G, int tid, int wave, int lane) {
    float* TW = (float*)(KWS() + WS_TW);
    for (int m = blockIdx.x * NTHREADS + tid; m < FFTN; m += G * NTHREADS) { const float x = (float)m * (2.0f / (float)FFTN); TW[2 * m] = cospif(x); TW[2 * m + 1] = -sinpif(x); }
    mod_phase(a, lds, G, tid, wave, lane);
    for (int it = blockIdx.x; it < 260; it += G) {
        if (it < 256) hy_filter_item(a, it >> 7, SEQ, (it & 127) * 64, KOUT() + (size_t)(it >> 7) * 2 * 1024 * SEQ, lds, tid, wave, lane);
        else hy_filter_item(a, 0, CTXL, (it - 256) * 64, (float*)(KWS() + WS_FTC), lds, tid, wave, lane);
    }
    convert_layer(a, 0, lds, G, wave, lane, G > 64 ? 4 : 0);
}

#define RN_SBASE(p) asm volatile("" : "+s"(p))
#define RN_LD4(base, j) (*(const f32x4*)((const char*)(base) + lo + 1024u * (j)))
#define RN_LD2(base, j) (*(const u32x2*)((const char*)(base) + (lo >> 1) + 512u * (j)))
#define RN_UNPK(v) ((f32x4){bf_lo((v).x), bf_hi((v).x), bf_lo((v).y), bf_hi((v).y)})
typedef _Float16 h16x2 __attribute__((ext_vector_type(2)));
__device__ __forceinline__ f32x4 x_unpack(u32x2 v) { const unsigned w0 = v.x, w1 = v.y;
    const h16x2 a = __builtin_bit_cast(h16x2, w0), b = __builtin_bit_cast(h16x2, w1); return (f32x4){(float)a.x, (float)a.y, (float)b.x, (float)b.y}; }
__device__ __forceinline__ u32x2 x_pack(f32x4 x) { h16x2 a, b; a.x = (_Float16)x.x; a.y = (_Float16)x.y; b.x = (_Float16)x.z; b.y = (_Float16)x.w; u32x2 o; o.x = __builtin_bit_cast(unsigned, a); o.y = __builtin_bit_cast(unsigned, b); return o; }
__device__ __forceinline__ void rownorm_phase(const Args& a, int G, int rows, bool first, bool writeh, bool final_out, const bf16* Y, float coef,
                                              const float* gate, const float* gpost, const float* shift, const float* scale, const float* gpre, bf16* H, int wave, int lane, bool junk = false, int nks = 0) {
    const bf16* part = (const bf16*)(KWS() + WS_VT);
    bf16* XB = (bf16*)(KWS() + WS_XB);
    const ptrdiff_t jo = junk ? (ptrdiff_t)(((bf16*)(KWS() + WS_Z)) - XB) : 0;
    const unsigned lo = (unsigned)lane * 16u;
    const int gw = blockIdx.x * NWAVES + wave, NGW = G * NWAVES;
    for (int mb = gw; mb < rows; mb += 2 * NGW) {
        int mm[2]; mm[0] = mb; mm[1] = (mb + NGW < rows) ? mb + NGW : mb;
        f32x4 x[2][4]; f32x4 y[2][4]; float ss[2]; int mr[2];
#pragma unroll
        for (int u = 0; u < 2; ++u) {
            const int m = mm[u]; mr[u] = m < MLAT ? (m >> 13) : 4;
            if (first) { const float* src = m < MLAT ? KIN(0) + (size_t)m * D : KIN(2) + (size_t)(m - MLAT) * D;
#pragma unroll
                for (int j = 0; j < 4; ++j) x[u][j] = RN_LD4(src, j);
            } else {
                ss[u] = 0.f;
                const bf16* yrow = Y + (size_t)m * D; const bf16* xrow = XB + (size_t)m * D;
#pragma unroll
                for (int j = 0; j < 4; ++j) { const u32x2 xv = RN_LD2(xrow, j); x[u][j] = x_unpack(xv); }
                if (nks > 0 && m >= MLAT) {
                    const bf16* pp = part + (size_t)(m - MLAT) * D;
#pragma unroll
                    for (int j = 0; j < 4; ++j) y[u][j] = (f32x4){0.f, 0.f, 0.f, 0.f};
                    if (nks == 11) {
                        u32x2 pv[11][4];
#pragma unroll
                        for (int ks = 0; ks < 11; ++ks) { const bf16* pk = pp + (size_t)ks * MCTX * D; RN_SBASE(pk);
#pragma unroll
                            for (int j = 0; j < 4; ++j) pv[ks][j] = RN_LD2(pk, j); }
#pragma unroll
                        for (int ks = 0; ks < 11; ++ks)
#pragma unroll
                            for (int j = 0; j < 4; ++j) y[u][j] = y[u][j] + RN_UNPK(pv[ks][j]);
                    } else {
                        u32x2 pv[4][4];
#pragma unroll
                        for (int ks = 0; ks < 4; ++ks) { const bf16* pk = pp + (size_t)ks * MCTX * D; RN_SBASE(pk);
#pragma unroll
                            for (int j = 0; j < 4; ++j) pv[ks][j] = RN_LD2(pk, j); }
#pragma unroll
                        for (int ks = 0; ks < 4; ++ks)
#pragma unroll
                            for (int j = 0; j < 4; ++j) y[u][j] = y[u][j] + RN_UNPK(pv[ks][j]);
                    }
                } else {
#pragma unroll
                    for (int j = 0; j < 4; ++j) { const u32x2 yv = RN_LD2(yrow, j); y[u][j] = RN_UNPK(yv); }
                }
#pragma unroll
                for (int j = 0; j < 4; ++j) ss[u] += (y[u][j].x * y[u][j].x + y[u][j].y * y[u][j].y) + (y[u][j].z * y[u][j].z + y[u][j].w * y[u][j].w);
            }
        }
        if (!first) {
#pragma unroll
            for (int u = 0; u < 2; ++u) {
                float msq = wave_sum(ss[u], lane) * (1.0f / D); asm volatile("" : "+v"(msq));
                const float rstd = 1.0f / sqrtf(msq + RMS_EPS) * coef;
                const float* grow = gate + (size_t)mr[u] * NMODW; RN_SBASE(grow); const float* gpo = gpost; RN_SBASE(gpo);
#pragma unroll
                for (int j = 0; j < 4; ++j) { const f32x4 g = RN_LD4(grow, j); const f32x4 gp = RN_LD4(gpo, j);
                    x[u][j] = x[u][j] + g * (y[u][j] * rstd) * gp; }
            }
        }
        if (final_out) {
#pragma unroll
            for (int u = 0; u < 2; ++u) { float* orow = KOUT() + (size_t)mm[u] * D; RN_SBASE(orow);
#pragma unroll
                for (int j = 0; j < 4; ++j) *(f32x4*)((char*)orow + lo + 1024u * j) = x[u][j]; }
        } else {
#pragma unroll
            for (int u = 0; u < 2; ++u) {
                bf16* xo = XB + (size_t)mm[u] * D + (mm[u] < MLAT ? jo : 0);
                if (!(junk && mm[u] >= MLAT)) {
#pragma unroll
                    for (int j = 0; j < 4; ++j) *(u32x2*)((char*)xo + (lo >> 1) + 512u * j) = x_pack(x[u][j]);
                }
            }
        }
        if (writeh && !junk) {
#pragma unroll
            for (int u = 0; u < 2; ++u) {
                float s2 = 0.f;
#pragma unroll
                for (int j = 0; j < 4; ++j) s2 += (x[u][j].x * x[u][j].x + x[u][j].y * x[u][j].y) + (x[u][j].z * x[u][j].z + x[u][j].w * x[u][j].w);
                float msq = wave_sum(s2, lane) * (1.0f / D); asm volatile("" : "+v"(msq));
                const float rstd = 1.0f / sqrtf(msq + RMS_EPS);
                const float* srow = scale + (size_t)mr[u] * NMODW; const float* hrow = shift + (size_t)mr[u] * NMODW; bf16* hout = H + (size_t)mm[u] * D; const float* gpr = gpre;
                RN_SBASE(srow); RN_SBASE(hrow); RN_SBASE(hout); RN_SBASE(gpr);
#pragma unroll
                for (int j = 0; j < 4; ++j) { const f32x4 gp = RN_LD4(gpr, j); const f32x4 sc = RN_LD4(srow, j); const f32x4 sh = RN_LD4(hrow, j);
                    const f32x4 h = (x[u][j] * rstd * gp) * (sc + 1.0f) + sh; u32x2 o; o.x = pk2(h.x, h.y); o.y = pk2(h.z, h.w); *(u32x2*)((char*)hout + (lo >> 1) + 512u * j) = o; }
            }
        }
    }
}


__device__ __forceinline__ f32x4 mfma16(bf16x8 a, bf16x8 b, f32x4 c) { return __builtin_amdgcn_mfma_f32_16x16x32_bf16(a, b, c, 0, 0, 0); }

constexpr int AB_KC = 0, AB_VC = 256 * 144, AB_RP = AB_VC + 64 * 528, AB_LDS_END = AB_RP + 15 * 31 * 4;
template <bool CTXQ>
__device__ __forceinline__ void attn_item(const bf16* __restrict__ Z, const bf16* __restrict__ VT, const float* __restrict__ rpb, bf16* MIX, int b, int r, int head, int qg, int lane, const LAS unsigned char* lc) {
    const int l15 = lane & 15, quad = lane >> 4;
    constexpr int NT = CTXQ ? 16 : 32;
    const int c0 = qg * 16;
    const int kc0 = min(max(c0 - 8, 0), 32);
    const int row_start = min(max(r - 4, 0), 120);
    const char* zlat = (const char*)(Z + (size_t)b * SEQ * ZW + head * 64);
    const char* zctx = (const char*)(Z + ((size_t)MLAT + b * CTXL) * ZW + head * 64);
    const unsigned lrow = (unsigned)(l15 * ZW + quad * 8) * 2u;
    const unsigned qoff = CTXQ ? (unsigned)(qg * 16 * ZW) * 2u + lrow : (unsigned)((r * 64 + c0) * ZW) * 2u + lrow;
    const char* qb = CTXQ ? zctx : zlat;
    const bf16x8 q0 = *(const bf16x8*)(qb + qoff), q1 = *(const bf16x8*)(qb + qoff + 64);
    f32x4 s[NT];
    const int krel = (l15 >> 2) * 8 + (l15 & 3);
    const unsigned krow = (unsigned)(krel * ZW + quad * 8) * 2u;
    const unsigned kwin = (unsigned)((row_start * 64 + kc0) * ZW + 512) * 2u + krow;
#pragma unroll
    for (int t = 0; t < NT; ++t) {
        bf16x8 k0, k1;
        if (!CTXQ && t < 16) { const unsigned o = kwin + (unsigned)(((t >> 1) * 64 + (t & 1) * 4) * ZW) * 2u; k0 = *(const bf16x8*)(zlat + o); k1 = *(const bf16x8*)(zlat + o + 64); }
        else if (CTXQ) { const unsigned o = (unsigned)(((t >> 1) * 32 + (t & 1) * 4) * ZW + 512) * 2u + krow; k0 = *(const bf16x8*)(zctx + o); k1 = *(const bf16x8*)(zctx + o + 64); }
        else { const LAS unsigned char* kp = lc + AB_KC + (((t - 16) >> 1) * 32 + (t & 1) * 4 + krel) * 144 + quad * 16; k0 = *(const LAS bf16x8*)kp; k1 = *(const LAS bf16x8*)(kp + 64); }
        f32x4 acc = {0.f, 0.f, 0.f, 0.f};
        acc = mfma16(k0, q0, acc); acc = mfma16(k1, q1, acc);
        s[t] = acc;
    }
    const int qc = c0 + l15, st = min(max(qc - 8, 0), 48);
    float mx = -INFINITY;
#pragma unroll
    for (int t = 0; t < NT; ++t)
#pragma unroll
        for (int jj = 0; jj < 4; ++jj) {
            float v = s[t][jj] * 0.125f;
            if (!CTXQ && t < 16) {
                const int kc = kc0 + quad * 8 + (t & 1) * 4 + jj;
                const bool valid = (kc >= st) && (kc < st + 16);
                const int dy = row_start + (t >> 1) - r + 7;
                const int dx = min(max(kc - qc + 15, 0), 30);
                const float bias = *(const LAS float*)(lc + AB_RP + (dy * 31 + dx) * 4);
                v = valid ? v + bias : -INFINITY;
            }
            s[t][jj] = v; mx = fmaxf(mx, v);
        }
    mx = fmaxf(mx, lane_xor_f(mx, 16, lane)); mx = fmaxf(mx, lane_xor_f(mx, 32, lane));
    float sum = 0.f;
#pragma unroll
    for (int t = 0; t < NT; ++t)
#pragma unroll
        for (int jj = 0; jj < 4; ++jj) { const float p = __expf(s[t][jj] - mx); s[t][jj] = p; sum += p; }
    sum += lane_xor_f(sum, 16, lane); sum += lane_xor_f(sum, 32, lane);
    f32x4 o[4];
#pragma unroll
    for (int dt = 0; dt < 4; ++dt) o[dt] = (f32x4){0.f, 0.f, 0.f, 0.f};
    const char* vb = (const char*)(VT + (size_t)(head * 64) * MTOT);
    const unsigned vrow = (unsigned)(l15 * MTOT + quad * 8) * 2u;
    const unsigned vwin = (unsigned)(b * SEQ + row_start * 64 + kc0) * 2u + vrow, vctx = (unsigned)(MLAT + b * CTXL) * 2u + vrow;
#pragma unroll
    for (int ks = 0; ks < NT / 2; ++ks) {
        u32x4 pw; pw.x = pk2(s[2 * ks][0], s[2 * ks][1]); pw.y = pk2(s[2 * ks][2], s[2 * ks][3]); pw.z = pk2(s[2 * ks + 1][0], s[2 * ks + 1][1]); pw.w = pk2(s[2 * ks + 1][2], s[2 * ks + 1][3]);
        const bf16x8 pa = __builtin_bit_cast(bf16x8, pw);
        unsigned co;
        if (!CTXQ && ks < 8) co = vwin + (unsigned)(ks * 64) * 2u; else co = vctx + (unsigned)((2 * ks - (CTXQ ? 0 : 16)) * 16) * 2u;
#pragma unroll
        for (int dt = 0; dt < 4; ++dt) {
            bf16x8 vw;
            if (!CTXQ && ks >= 8) vw = *(const LAS bf16x8*)(lc + AB_VC + (dt * 16 + l15) * 528 + ((2 * ks - 16) * 16 + quad * 8) * 2);
            else vw = *(const bf16x8*)(vb + co + (unsigned)(dt * 16 * MTOT) * 2u);
            o[dt] = mfma16(vw, pa, o[dt]);
        }
    }
    bf16* ob = CTXQ ? MIX + ((size_t)MLAT + b * CTXL + qg * 16) * D + head * 64 : MIX + ((size_t)b * SEQ + r * 64 + c0) * D + head * 64;
    const float inv = 1.0f / sum;
#pragma unroll
    for (int dt = 0; dt < 4; ++dt) { u32x2 w; w.x = pk2(o[dt][0] * inv, o[dt][1] * inv); w.y = pk2(o[dt][2] * inv, o[dt][3] * inv);
        *(u32x2*)(ob + (unsigned)(l15 * D + dt * 16 + quad * 4)) = w; }
}

__device__ __forceinline__ void ab_core_phase(const Args& a, int l, LAS unsigned char* lds, int G, int tid, int wave, int lane) {
    const bf16* Z = (const bf16*)(KWS() + WS_Z); const bf16* VT = (const bf16*)(KWS() + WS_VT); bf16* MIX = (bf16*)(KWS() + WS_H);
    const int j = l >> 1;
    const float* rpb = KIN(11) + (size_t)j * 8 * 15 * 31;
    const float* cw = KIN(12) + (size_t)j * 3 * 512;
    const bool ctxq = (l == 0);
    const int gw = blockIdx.x * NWAVES + wave, NGW = G * NWAVES;
    for (int job = blockIdx.x; job < NB * 8 * 8; job += G) {
        const int b = job >> 6, head = (job >> 3) & 7, r0 = (job & 7) * 16;
        __syncthreads();
        for (int e = tid; e < 2048; e += NTHREADS) { const int jj = e >> 3, c = e & 7;
            *(LAS u32x4*)(lds + AB_KC + jj * 144 + c * 16) = *(const u32x4*)(Z + ((size_t)MLAT + b * CTXL + jj) * ZW + 512 + head * 64 + c * 8); }
        for (int e = tid; e < 2048; e += NTHREADS) { const int d = e >> 5, c = e & 31;
            *(LAS u32x4*)(lds + AB_VC + d * 528 + c * 16) = *(const u32x4*)(VT + (size_t)(head * 64 + d) * MTOT + MLAT + b * CTXL + c * 8); }
        if (tid < 15 * 31) *(LAS float*)(lds + AB_RP + tid * 4) = rpb[head * 15 * 31 + tid];
        __syncthreads();
        for (int i = wave; i < 64; i += NWAVES) attn_item<false>(Z, VT, rpb, MIX, b, r0 + (i >> 2), head, i & 3, lane, lds);
    }
    if (ctxq) for (int it = gw; it < NB * 8 * 16; it += NGW) attn_item<true>(Z, VT, rpb, MIX, it >> 7, 0, (it >> 4) & 7, it & 15, lane, lds);
    const int rows = ctxq ? MTOT : MLAT;
    float cwr[3][8];
#pragma unroll
    for (int d = 0; d < 3; ++d)
#pragma unroll
        for (int e = 0; e < 8; ++e) cwr[d][e] = cw[d * 512 + (tid & 63) * 8 + e];
#pragma unroll 4
    for (int idx = blockIdx.x * NTHREADS + tid; idx < rows * 64; idx += G * NTHREADS) {
        const int m = idx >> 6, ch = (idx & 63) * 8;
        const int pos = m < MLAT ? (m & (SEQ - 1)) : ((m - MLAT) & (CTXL - 1)); const int len = m < MLAT ? SEQ : CTXL;
        const bf16* zr = Z + (size_t)m * ZW;
        float acc[8] = {0.f, 0.f, 0.f, 0.f, 0.f, 0.f, 0.f, 0.f};
#pragma unroll
        for (int d = 0; d < 3; ++d) {
            const int p = pos + d - 1;
            if (p >= 0 && p < len) {
                const u32x4 gcv = *(const u32x4*)(zr + (ptrdiff_t)(d - 1) * ZW + 2048 + ch), xbv = *(const u32x4*)(zr + (ptrdiff_t)(d - 1) * ZW + 2560 + ch);
                float gc[8], xb[8]; UNPACK8(gcv, gc); UNPACK8(xbv, xb);
#pragma unroll
                for (int e = 0; e < 8; ++e) acc[e] += cwr[d][e] * (gc[e] * xb[e]);
            }
        }
        const u32x4 gbv = *(const u32x4*)(zr + 1536 + ch); float gb[8]; UNPACK8(gbv, gb);
        u32x4 o; o.x = pk2(gb[0] * acc[0], gb[1] * acc[1]); o.y = pk2(gb[2] * acc[2], gb[3] * acc[3]); o.z = pk2(gb[4] * acc[4], gb[5] * acc[5]); o.w = pk2(gb[6] * acc[6], gb[7] * acc[7]);
        *(u32x4*)(MIX + (size_t)m * D + 512 + ch) = o;
    }
}

__device__ __forceinline__ void shortconv8(const bf16* __restrict__ Z, size_t rowbase, int pos, int len, int col, const float* __restrict__ sw, float (&out)[8]) {
#pragma unroll
    for (int e = 0; e < 8; ++e) out[e] = 0.f;
#pragma unroll
    for (int d = 0; d < 3; ++d) {
        const int p = pos + d - 1;
        if (p >= 0 && p < len) {
            const u32x4 zv = *(const u32x4*)(Z + (rowbase + p) * ZW + col); float z[8]; UNPACK8(zv, z);
            const f32x4 w0 = *(const f32x4*)(sw + d * ZW + col), w1 = *(const f32x4*)(sw + d * ZW + col + 4);
            out[0] += w0.x * z[0]; out[1] += w0.y * z[1]; out[2] += w0.z * z[2]; out[3] += w0.w * z[3];
            out[4] += w1.x * z[4]; out[5] += w1.y * z[5]; out[6] += w1.z * z[6]; out[7] += w1.w * z[7];
        }
    }
}
__device__ __forceinline__ void load_taps8(const float* __restrict__ sw, int col, float (&w)[3][8]) {
#pragma unroll
    for (int d = 0; d < 3; ++d) { const f32x4 w0 = *(const f32x4*)(sw + d * ZW + col), w1 = *(const f32x4*)(sw + d * ZW + col + 4);
        w[d][0] = w0.x; w[d][1] = w0.y; w[d][2] = w0.z; w[d][3] = w0.w; w[d][4] = w1.x; w[d][5] = w1.y; w[d][6] = w1.z; w[d][7] = w1.w; }
}
__device__ __forceinline__ void shortconv8w(const bf16* __restrict__ Z, size_t rowbase, int pos, int len, int col, const float (&w)[3][8], float (&out)[8]) {
#pragma unroll
    for (int e = 0; e < 8; ++e) out[e] = 0.f;
#pragma unroll
    for (int d = 0; d < 3; ++d) {
        const int p = pos + d - 1;
        if (p >= 0 && p < len) {
            const u32x4 zv = *(const u32x4*)(Z + (rowbase + p) * ZW + col); float z[8]; UNPACK8(zv, z);
#pragma unroll
            for (int e = 0; e < 8; ++e) out[e] += w[d][e] * z[e];
        }
    }
}
constexpr int HY_TT = 256, HY_TP = HY_TT + 1;
__device__ __forceinline__ void hy_pre_phase(const Args& a, int l, LAS unsigned char* lds, int G, int tid) {
    const bf16* Z = (const bf16*)(KWS() + WS_Z); bf16* UT = (bf16*)(KWS() + WS_Y);
    const float* sw = KIN(15) + (size_t)(l >> 1) * 3 * ZW;
    LAS float* T = (LAS float*)lds;
    for (int it = blockIdx.x; it < NB * (SEQ / HY_TT) * 16; it += G) {
        const int b = it >> 9, t0 = ((it >> 4) & 31) * HY_TT, c0 = (it & 15) * 64;
        float wx1[3][8], wv[3][8]; load_taps8(sw, 1024 + c0 + (tid & 7) * 8, wx1); load_taps8(sw, 2048 + c0 + (tid & 7) * 8, wv);
#pragma unroll 2
        for (int e = tid; e < HY_TT * 8; e += NTHREADS) {
            const int tl = e >> 3, cc = (e & 7) * 8; float x1[8], v[8];
            shortconv8w(Z, (size_t)b * SEQ, t0 + tl, SEQ, 1024 + c0 + cc, wx1, x1);
            shortconv8w(Z, (size_t)b * SEQ, t0 + tl, SEQ, 2048 + c0 + cc, wv, v);
#pragma unroll
            for (int i = 0; i < 8; ++i) T[(cc + i) * HY_TP + tl] = x1[i] * v[i];
        }
        __syncthreads();
        for (int e = tid; e < 64 * (HY_TT / 8); e += NTHREADS) {
            const int c = e >> 5, tch = (e & 31) * 8; const LAS float* s = T + c * HY_TP + tch;
            u32x4 o; o.x = pk2(s[0], s[1]); o.y = pk2(s[2], s[3]); o.z = pk2(s[4], s[5]); o.w = pk2(s[6], s[7]);
            *(u32x4*)(UT + ((size_t)(b * 1024 + c0 + c)) * SEQ + t0 + tch) = o;
        }
        __syncthreads();
    }
}
__device__ __forceinline__ void hy_post_phase(const Args& a, int l, LAS unsigned char* lds, int G, int tid) {
    const bf16* Z = (const bf16*)(KWS() + WS_Z); const bf16* UT = (const bf16*)(KWS() + WS_Y); bf16* MIX = (bf16*)(KWS() + WS_H);
    const float* sw = KIN(15) + (size_t)(l >> 1) * 3 * ZW;
    LAS float* T = (LAS float*)lds;
    for (int it = blockIdx.x; it < NB * (SEQ / HY_TT) * 16; it += G) {
        const int b = it >> 9, t0 = ((it >> 4) & 31) * HY_TT, c0 = (it & 15) * 64;
#pragma unroll 2
        for (int e = tid; e < 64 * (HY_TT / 8); e += NTHREADS) {
            const int c = e >> 5, tch = (e & 31) * 8;
            const u32x4 uv = *(const u32x4*)(UT + ((size_t)(b * 1024 + c0 + c)) * SEQ + t0 + tch); float f[8]; UNPACK8(uv, f);
#pragma unroll
            for (int i = 0; i < 8; ++i) T[c * HY_TP + tch + i] = f[i];
        }
        __syncthreads();
        float wx0[3][8]; load_taps8(sw, c0 + (tid & 7) * 8, wx0);
#pragma unroll 2
        for (int e = tid; e < HY_TT * 8; e += NTHREADS) {
            const int tl = e >> 3, cc = (e & 7) * 8; float x0[8];
            shortconv8w(Z, (size_t)b * SEQ, t0 + tl, SEQ, c0 + cc, wx0, x0);
            float y[8];
#pragma unroll
            for (int i = 0; i < 8; ++i) y[i] = x0[i] * T[(cc + i) * HY_TP + tl];
            u32x4 o; o.x = pk2(y[0], y[1]); o.y = pk2(y[2], y[3]); o.z = pk2(y[4], y[5]); o.w = pk2(y[6], y[7]);
            *(u32x4*)(MIX + ((size_t)b * SEQ + t0 + tl) * D + c0 + cc) = o;
        }
        __syncthreads();
    }
}

typedef float cf2 __attribute__((ext_vector_type(2)));
__device__ __forceinline__ cf2 mk2(float x, float y) { cf2 r; r.x = x; r.y = y; return r; }
#define FFT_HD __device__ __forceinline__
#define FFT_CX LAS
#define FFT_LAUNDER(x) asm volatile("" : "+v"(x))
FFT_HD cf2 c_add(cf2 a, cf2 b) { return mk2(a.x + b.x, a.y + b.y); }
FFT_HD cf2 c_sub(cf2 a, cf2 b) { return mk2(a.x - b.x, a.y - b.y); }
FFT_HD cf2 c_mul(cf2 a, cf2 b) { return mk2(a.x * b.x - a.y * b.y, a.x * b.y + a.y * b.x); }
FFT_HD cf2 c_mulc(cf2 a, cf2 b) { return mk2(a.x * b.x + a.y * b.y, a.y * b.x - a.x * b.y); }
template <bool INV> FFT_HD cf2 c_rot(cf2 a) { return INV ? mk2(-a.y, a.x) : mk2(a.y, -a.x); }
template <bool INV> FFT_HD cf2 c_tw(cf2 a, float c, float s) { return INV ? mk2(a.x * c + a.y * s, a.y * c - a.x * s) : mk2(a.x * c - a.y * s, a.x * s + a.y * c); }
template <bool INV> FFT_HD void bf4(cf2& a0, cf2& a1, cf2& a2, cf2& a3) {
    const cf2 t0 = c_add(a0, a2), t1 = c_sub(a0, a2), t2 = c_add(a1, a3), t3 = c_rot<INV>(c_sub(a1, a3));
    a0 = c_add(t0, t2); a1 = c_add(t1, t3); a2 = c_sub(t0, t2); a3 = c_sub(t1, t3);
}
template <bool INV> FFT_HD void dft16(cf2 (&a)[16]) {
#pragma unroll
    for (int q2 = 0; q2 < 4; ++q2) bf4<INV>(a[q2], a[q2 + 4], a[q2 + 8], a[q2 + 12]);
    float C1 = 0.92387953251128674f, C2 = 0.70710678118654752f, C3 = 0.38268343236508977f;
    FFT_LAUNDER(C1); FFT_LAUNDER(C2); FFT_LAUNDER(C3);
    const float S1 = -C3, S2 = -C2, S3 = -C1;
    a[1 + 4] = c_tw<INV>(a[1 + 4], C1, S1); a[1 + 8] = c_tw<INV>(a[1 + 8], C2, S2); a[1 + 12] = c_tw<INV>(a[1 + 12], C3, S3);
    a[2 + 4] = c_tw<INV>(a[2 + 4], C2, S2); a[2 + 8] = c_rot<INV>(a[2 + 8]);        a[2 + 12] = c_tw<INV>(a[2 + 12], -C2, S2);
    a[3 + 4] = c_tw<INV>(a[3 + 4], C3, S3); a[3 + 8] = c_tw<INV>(a[3 + 8], -C2, S2); a[3 + 12] = c_tw<INV>(a[3 + 12], -C1, -S1);
#pragma unroll
    for (int r1 = 0; r1 < 4; ++r1) bf4<INV>(a[4 * r1], a[4 * r1 + 1], a[4 * r1 + 2], a[4 * r1 + 3]);
}
#define FFT_PERM(r) ((((r) & 3) << 2) | ((r) >> 2))
#define FFT_PHYS(n) ((n) + ((n) >> 4))
FFT_HD void tw_pow16(cf2 w1, cf2 (&w)[16]) {
    w[0] = mk2(1.f, 0.f); w[1] = w1; w[2] = c_mul(w1, w1); w[3] = c_mul(w[2], w1); w[4] = c_mul(w[2], w[2]); w[5] = c_mul(w[4], w1); w[6] = c_mul(w[3], w[3]); w[7] = c_mul(w[4], w[3]);
    w[8] = c_mul(w[4], w[4]);
#pragma unroll
    for (int r = 9; r < 16; ++r) w[r] = c_mul(w[8], w[r - 8]);
}
FFT_HD void r16_fwd(FFT_CX cf2* cx, int base, int stride, cf2 w1, bool notw) {
    cf2 a[16];
#pragma unroll
    for (int q = 0; q < 16; ++q) a[q] = cx[base + q * stride];
    dft16<false>(a);
    if (notw) {
#pragma unroll
        for (int r = 0; r < 16; ++r) cx[base + r * stride] = a[FFT_PERM(r)];
    } else {
        cf2 w[16]; tw_pow16(w1, w);
#pragma unroll
        for (int r = 0; r < 16; ++r) cx[base + r * stride] = r == 0 ? a[0] : c_mul(a[FFT_PERM(r)], w[r]);
    }
}
FFT_HD void r16_inv(FFT_CX cf2* cx, int base, int stride, cf2 w1) {
    cf2 a[16]; cf2 w[16]; tw_pow16(w1, w);
#pragma unroll
    for (int r = 0; r < 16; ++r) { const cf2 v = cx[base + r * stride]; a[r] = r == 0 ? v : c_mulc(v, w[r]); }
    dft16<true>(a);
#pragma unroll
    for (int q = 0; q < 16; ++q) cx[base + q * stride] = a[FFT_PERM(q)];
}
__device__ __forceinline__ void hy_fft_phase(const Args& a, int l, LAS unsigned char* lds, int G, int tid, bool junk) {
    const int hl = l >> 1;
    bf16* UT = (bf16*)(KWS() + WS_Y); const ptrdiff_t dsto = junk ? (ptrdiff_t)(WS_H / 2) - (ptrdiff_t)(WS_Y / 2) : 0;
    const float* FT = (const float*)KOUT() + (size_t)hl * 2 * 1024 * SEQ;
    const cf2* TW = (const cf2*)(KWS() + WS_TW);
    cf2* KF = (cf2*)(KWS() + WS_KFS) + (size_t)blockIdx.x * FFTN;
    const float* bias = KIN(24) + hl * 1024;
    LAS cf2* cx = (LAS cf2*)lds;
    cf2 tw0[8];
#pragma unroll
    for (int k = 0; k < 8; ++k) tw0[k] = TW[8 * tid + k];
    const cf2 tw1 = TW[4 * (tid & 255)], tw2 = TW[64 * (tid & 15)];
    for (int c = blockIdx.x; c < 1024; c += G) {
        const float* hf = FT + (size_t)c * SEQ; const float* hb = FT + (size_t)(1024 + c) * SEQ;
#pragma unroll
        for (int k = 0; k < 8; ++k) {
            int t_ = tid; asm volatile("" : "+v"(t_)); const int j = 8 * t_ + k;
            const unsigned jb = (unsigned)j * 4u;
            cf2 a0 = mk2(*(const float*)((const char*)hf + jb), 0.f), a1 = mk2(*(const float*)((const char*)hf + jb + 16384u), 0.f), a2 = mk2(j == 0 ? 0.f : *(const float*)((const char*)hb + (32768u - jb)), 0.f), a3 = mk2(*(const float*)((const char*)hb + (16384u - jb)), 0.f);
            bf4<false>(a0, a1, a2, a3);
            cf2 w1 = tw0[k]; asm volatile("" : "+v"(w1)); const cf2 w2 = c_mul(w1, w1), w3 = c_mul(w2, w1);
            { const int pj = FFT_PHYS(j); cx[pj] = a0; cx[pj + 4352] = c_mul(a1, w1); cx[pj + 8704] = c_mul(a2, w2); cx[pj + 13056] = c_mul(a3, w3); }
        }
        __syncthreads();
#pragma unroll
        for (int k = 0; k < 2; ++k) { int t_ = tid; asm volatile("" : "+v"(t_)); const int i = t_ + 512 * k, n_ = (i >> 8) * 4096 + (i & 255); cf2 w_ = tw1; asm volatile("" : "+v"(w_)); r16_fwd(cx, FFT_PHYS(n_), 272, w_, false); }
        __syncthreads();
#pragma unroll
        for (int k = 0; k < 2; ++k) { int t_ = tid; asm volatile("" : "+v"(t_)); const int i = t_ + 512 * k, n_ = (i >> 4) * 256 + (i & 15); cf2 w_ = tw2; asm volatile("" : "+v"(w_)); r16_fwd(cx, FFT_PHYS(n_), 17, w_, false); }
        LDS_WAIT(); asm volatile("" ::: "memory");
#pragma unroll
        for (int k = 0; k < 2; ++k) {
            int t_ = tid; asm volatile("" : "+v"(t_)); const int i = t_ + 512 * k; cf2 v[16];
#pragma unroll
            for (int q = 0; q < 16; ++q) v[q] = cx[17 * i + q];
            dft16<false>(v);
#pragma unroll
            for (int r = 0; r < 16; ++r) { const cf2 y = v[FFT_PERM(r)]; *(cf2*)((char*)KF + (unsigned)i * 128u + r * 8) = mk2(y.x * (1.0f / FFTN), y.y * (1.0f / FFTN)); }
        }
        __syncthreads();
        const float bc = bias[c];
        for (int pair = 0; pair < 2; ++pair) {
            bf16* u0 = UT + ((size_t)((2 * pair) * 1024 + c)) * SEQ; bf16* u1 = UT + ((size_t)((2 * pair + 1) * 1024 + c)) * SEQ;
            {
                int t_ = tid; asm volatile("" : "+v"(t_)); const unsigned jb = (unsigned)t_ * 16u; const int pj0 = 8 * t_ + (t_ >> 1);
                const u32x4 A0 = *(const u32x4*)((const char*)u0 + jb), A1 = *(const u32x4*)((const char*)u1 + jb), B0 = *(const u32x4*)((const char*)u0 + jb + 8192u), B1 = *(const u32x4*)((const char*)u1 + jb + 8192u);
                float fa0[8], fa1[8], fb0[8], fb1[8]; UNPACK8(A0, fa0); UNPACK8(A1, fa1); UNPACK8(B0, fb0); UNPACK8(B1, fb1);
#pragma unroll
                for (int k = 0; k < 8; ++k) {
                    cf2 a0 = mk2(fa0[k], fa1[k]), a1 = mk2(fb0[k], fb1[k]), a2 = mk2(0.f, 0.f), a3 = mk2(0.f, 0.f);
                    bf4<false>(a0, a1, a2, a3);
                    cf2 w1 = tw0[k]; asm volatile("" : "+v"(w1)); const cf2 w2 = c_mul(w1, w1), w3 = c_mul(w2, w1);
                    cx[pj0 + k] = a0; cx[pj0 + k + 4352] = c_mul(a1, w1); cx[pj0 + k + 8704] = c_mul(a2, w2); cx[pj0 + k + 13056] = c_mul(a3, w3);
                }
            }
            __syncthreads();
#pragma unroll
            for (int k = 0; k < 2; ++k) { int t_ = tid; asm volatile("" : "+v"(t_)); const int i = t_ + 512 * k, n_ = (i >> 8) * 4096 + (i & 255); cf2 w_ = tw1; asm volatile("" : "+v"(w_)); r16_fwd(cx, FFT_PHYS(n_), 272, w_, false); }
            __syncthreads();
#pragma unroll
            for (int k = 0; k < 2; ++k) { int t_ = tid; asm volatile("" : "+v"(t_)); const int i = t_ + 512 * k, n_ = (i >> 4) * 256 + (i & 15); cf2 w_ = tw2; asm volatile("" : "+v"(w_)); r16_fwd(cx, FFT_PHYS(n_), 17, w_, false); }
            LDS_WAIT(); asm volatile("" ::: "memory");
#pragma unroll
            for (int k = 0; k < 2; ++k) {
                int t_ = tid; asm volatile("" : "+v"(t_)); const int i = t_ + 512 * k; cf2 v[16], w[16];
#pragma unroll
                for (int q = 0; q < 16; ++q) v[q] = cx[17 * i + q];
                dft16<false>(v);
#pragma unroll
                for (int r = 0; r < 16; ++r) w[r] = c_mul(v[FFT_PERM(r)], *(const cf2*)((const char*)KF + (unsigned)i * 128u + r * 8));
                dft16<true>(w);
#pragma unroll
                for (int q = 0; q < 16; ++q) cx[17 * i + q] = w[FFT_PERM(q)];
            }
            LDS_WAIT(); asm volatile("" ::: "memory");
#pragma unroll
            for (int k = 0; k < 2; ++k) { int t_ = tid; asm volatile("" : "+v"(t_)); const int i = t_ + 512 * k, n_ = (i >> 4) * 256 + (i & 15); cf2 w_ = tw2; asm volatile("" : "+v"(w_)); r16_inv(cx, FFT_PHYS(n_), 17, w_); }
            __syncthreads();
#pragma unroll
            for (int k = 0; k < 2; ++k) { int t_ = tid; asm volatile("" : "+v"(t_)); const int i = t_ + 512 * k, n_ = (i >> 8) * 4096 + (i & 255); cf2 w_ = tw1; asm volatile("" : "+v"(w_)); r16_inv(cx, FFT_PHYS(n_), 272, w_); }
            __syncthreads();
            {
                int t_ = tid; asm volatile("" : "+v"(t_)); const unsigned jb = (unsigned)t_ * 16u; const int pj0 = 8 * t_ + (t_ >> 1);
                const u32x4 A0 = *(const u32x4*)((const char*)u0 + jb), A1 = *(const u32x4*)((const char*)u1 + jb), B0 = *(const u32x4*)((const char*)u0 + jb + 8192u), B1 = *(const u32x4*)((const char*)u1 + jb + 8192u);
                float fa0[8], fa1[8], fb0[8], fb1[8]; UNPACK8(A0, fa0); UNPACK8(A1, fa1); UNPACK8(B0, fb0); UNPACK8(B1, fb1);
#pragma unroll
                for (int k = 0; k < 8; ++k) {
                    cf2 w1 = tw0[k]; asm volatile("" : "+v"(w1)); const cf2 w2 = c_mul(w1, w1), w3 = c_mul(w2, w1);
                    cf2 b0 = cx[pj0 + k], b1 = c_mulc(cx[pj0 + k + 4352], w1), b2 = c_mulc(cx[pj0 + k + 8704], w2), b3 = c_mulc(cx[pj0 + k + 13056], w3);
                    bf4<true>(b0, b1, b2, b3);
                    fa0[k] = b0.x + fa0[k] * bc; fa1[k] = b0.y + fa1[k] * bc; fb0[k] = b1.x + fb0[k] * bc; fb1[k] = b1.y + fb1[k] * bc;
                }
                char* d0 = (char*)(u0 + dsto); char* d1 = (char*)(u1 + dsto);
                u32x4 o; o.x = pk2(fa0[0], fa0[1]); o.y = pk2(fa0[2], fa0[3]); o.z = pk2(fa0[4], fa0[5]); o.w = pk2(fa0[6], fa0[7]); *(u32x4*)(d0 + jb) = o;
                o.x = pk2(fa1[0], fa1[1]); o.y = pk2(fa1[2], fa1[3]); o.z = pk2(fa1[4], fa1[5]); o.w = pk2(fa1[6], fa1[7]); *(u32x4*)(d1 + jb) = o;
                o.x = pk2(fb0[0], fb0[1]); o.y = pk2(fb0[2], fb0[3]); o.z = pk2(fb0[4], fb0[5]); o.w = pk2(fb0[6], fb0[7]); *(u32x4*)(d0 + jb + 8192u) = o;
                o.x = pk2(fb1[0], fb1[1]); o.y = pk2(fb1[2], fb1[3]); o.z = pk2(fb1[4], fb1[5]); o.w = pk2(fb1[6], fb1[7]); *(u32x4*)(d1 + jb + 8192u) = o;
            }
            __syncthreads();
        }
    }
}
__device__ __forceinline__ void hy_ctx_phase(const Args& a, int l, LAS unsigned char* lds, int G, int tid) {
    const int hl = l >> 1;
    const bf16* Z = (const bf16*)(KWS() + WS_Z); bf16* MIX = (bf16*)(KWS() + WS_H);
    const float* sw = KIN(15) + (size_t)hl * 3 * ZW; const float* FTC = (const float*)(KWS() + WS_FTC); const float* bias = KIN(24) + hl * 1024;
    LAS float* U = (LAS float*)lds;
    LAS float* KK = (LAS float*)(lds + 16384);
    for (int it = blockIdx.x; it < NB * 64; it += G) {
        const int b = it >> 6, c0 = (it & 63) * 16; const size_t rb = (size_t)MLAT + b * CTXL;
        { const int jpos = tid >> 1, cc = (tid & 1) * 8; float x1[8], v[8];
            shortconv8(Z, rb, jpos, CTXL, 1024 + c0 + cc, sw, x1); shortconv8(Z, rb, jpos, CTXL, 2048 + c0 + cc, sw, v);
#pragma unroll
            for (int i = 0; i < 8; ++i) U[jpos * 16 + cc + i] = x1[i] * v[i]; }
        for (int e = tid; e < 16 * 511; e += NTHREADS) { const int cch = e / 511, d = e % 511 - 255;
            KK[(d + 263) * 17 + cch] = d >= 0 ? FTC[(size_t)(c0 + cch) * CTXL + d] : FTC[(size_t)(1024 + c0 + cch) * CTXL - d]; }
        __syncthreads();
        const int cc = tid & 15, t0 = (tid >> 4) * 8;
        float acc[8] = {0.f, 0.f, 0.f, 0.f, 0.f, 0.f, 0.f, 0.f};
        for (int j0 = 0; j0 < CTXL; j0 += 8) {
            float k16[15], u8[8];
#pragma unroll
            for (int m = 0; m < 15; ++m) k16[m] = KK[(t0 - j0 - 7 + m + 263) * 17 + cc];
#pragma unroll
            for (int s = 0; s < 8; ++s) u8[s] = U[(j0 + s) * 16 + cc];
#pragma unroll
            for (int s = 0; s < 8; ++s)
#pragma unroll
                for (int i = 0; i < 8; ++i) acc[i] += k16[7 - s + i] * u8[s];
        }
#pragma unroll
        for (int i = 0; i < 8; ++i) {
            const int t = t0 + i; float x0 = 0.f;
#pragma unroll
            for (int d = 0; d < 3; ++d) { const int p = t + d - 1; if (p >= 0 && p < CTXL) x0 += sw[d * ZW + c0 + cc] * bf1(Z[(rb + p) * ZW + c0 + cc]); }
            MIX[(rb + t) * D + c0 + cc] = f2bf(x0 * (acc[i] + U[t * 16 + cc] * bias[c0 + cc]));
        }
        __syncthreads();
    }
}

__global__ void __launch_bounds__(NTHREADS, 2) fwd_megakernel(Args a) {
    extern __shared__ __attribute__((aligned(16))) unsigned char lds_raw[];
    LAS unsigned char* lds = (LAS unsigned char*)lds_raw;
    cg::grid_group grid = cg::this_grid();
    volatile LAS unsigned* misc = (volatile LAS unsigned*)(lds + 139264);
    if (threadIdx.x < 64) misc[threadIdx.x] = 0u;
    __syncthreads();
    (void)xcd_barrier_post((unsigned*)(KWS() + WS_BAR), misc + 8);
#define GRID_BARRIER() do { XcdBarrier xb_; xb_.bar = (unsigned*)(KWS() + WS_BAR); xb_.x = xb_xcc_id(); xb_.st = (volatile LAS unsigned*)(lds + 139264) + 8; xcd_barrier(xb_); } while (0)
    const int G = gridDim.x;
#define FRESH_TID() int tid = threadIdx.x; asm volatile("" : "+v"(tid)); const int lane = tid & 63, wave = __builtin_amdgcn_readfirstlane(tid >> 6)
#undef ws
#define ws KWS()
#define H ((bf16*)(ws + WS_H))
#define Y ((bf16*)(ws + WS_Y))
#define Zb ((bf16*)(ws + WS_Z))
#define VT ((bf16*)(ws + WS_VT))
#define MOD ((const float*)(ws + WS_MOD))
#define NG KIN(6)

    { FRESH_TID();
#ifndef SKIP_PRO
    for (int rep = 0; rep < REP_PRO; ++rep) prologue(a, lds, G, tid, wave, lane);
#endif
    }
    if (gridDim.x == 0x7fffffffu) grid.sync();
    GRID_BARRIER();
    { FRESH_TID();
    for (int rep = 0; rep < REP_R0; ++rep) rownorm_phase(a, G, MTOT, true, true, false, nullptr, 0.f, nullptr, nullptr, MOD + 0 * 1024, MOD + 1 * 1024, NG + 0 * D, H, wave, lane);
    }
    GRID_BARRIER();

    for (int l = 0; l < 4; ++l) {
        const bool even = !(l & 1);
        const int rows1 = (l <= 2) ? MTOT : MLAT, rows2 = (l < 2) ? MTOT : MLAT;
        const float* modl = MOD + (size_t)l * 5 * NMODW; const float* ng = NG + (size_t)l * 6 * D;
        const unsigned long long prog = even ? 0xBA98764321ull : 0xBA987EDC4321ull;
        const int nsteps = even ? 10 : 12;
        for (int s2 = 0; s2 < nsteps * REP_MAX; ++s2) {
            const int s = s2 / REP_MAX, rep = s2 % REP_MAX;
            const int kind = (int)((prog >> (4 * s)) & 15ull);
            {
                const bool isgemm = (kind == 1 || kind == 9 || kind == 2 || kind == 10 || kind == 4 || kind == 5 || kind == 7);
                const int nrep = isgemm ? REP_GEMM : (kind == 6 ? REP_AB : ((kind == 12 || kind == 14) ? REP_PREPOST : (kind == 13 ? REP_FFT : ((kind == 3 || kind == 8 || kind == 11) ? REP_RN : 1))));
                if (rep >= nrep) continue;
            }
            FRESH_TID();
            if (kind == 1 || kind == 9) {
                const bool second = (kind == 9);
                EpiSwiglu E{Zb, DFF};
#ifndef SKIP_GU
                run_gemm<EpiSwiglu>(lds, H, (const bf16*)(ws + WS_W + (second ? WO_GU2 : WO_GU1)), second ? rows2 : rows1, 2 * DFF, D, G, E);
#endif
            } else if (kind == 2 || kind == 10 || kind == 4 || kind == 7) {
                const bf16* A; const bf16* Bt; int M, N, K; bf16* O; int ldc;
                if (kind == 2)       { A = Zb; Bt = (const bf16*)(ws + WS_W + WO_D1); M = rows1; N = D; K = DFF; O = Y; ldc = D; }
                else if (kind == 10) { A = Zb; Bt = (const bf16*)(ws + WS_W + WO_D2); M = rows2; N = D; K = DFF; O = Y; ldc = D; }
                else if (kind == 4)  { A = H; Bt = (const bf16*)(ws + WS_W + WO_IN); M = rows1; N = ZW; K = D; O = Zb; ldc = ZW; }
                else                 { A = H; Bt = (const bf16*)(ws + WS_W + WO_IN); M = 0; N = 0; K = D; O = Y; ldc = D; }
                if (kind == 7)       { A = H; Bt = (const bf16*)(ws + WS_W + WO_OUT); M = rows2; N = D; K = D; O = Y; ldc = D; }
                const bool ctx_split = (kind == 2 || kind == 10 || kind == 7) && M == MTOT;
                if (ctx_split) M = MLAT;
                const bool with_vt = (kind == 4) && even;
                static_assert(WS_H - (WS_W + WO_IN + (size_t)1024 * D * 2) == (size_t)51 * 256 * D * 2 && WS_H - (WS_W + WO_IN) == (size_t)55 * 256 * D * 2, "V^T units reach W_v / H through tile indices");
#ifndef SKIP_GB
                {
                    pg8::Gemm g{A, Bt, M, N, K, K};
                    UniOrder S; S.so.init(M, with_vt ? N - 512 : N, G, (int)blockIdx.x); S.KS = ctx_split ? K / 256 : 0; S.nvt = with_vt ? 2 * (M / 256) : 0;
                    EpiZV E{pg8::EpiBf16<0>{O, ldc, nullptr, 0, 0, 1.f},
                            with_vt ? pg8::EpiBf16<0>{VT, MTOT, nullptr, 0, 0, 1.f} : pg8::EpiBf16<0>{(bf16*)(ws + WS_VT), D, nullptr, D, (size_t)MCTX * D, 1.f}, with_vt ? 51 : -128};
                    pg8::gemm_phase<EpiZV, UniOrder, true, true>(lds, g, S, E);
                }
#endif
            } else if (kind == 3) {
                rownorm_phase(a, G, rows1, false, true, false, Y, 0.5f, modl + 2 * 1024, ng + 1 * D, modl + 3 * 1024, modl + 4 * 1024, ng + 2 * D, H, wave, lane, rep + 1 < REP_RN, rows1 == MTOT ? DFF / 256 : 0);
            } else if (kind == 8) {
                rownorm_phase(a, G, rows2, false, true, false, Y, 1.0f, modl + 5 * 1024, ng + 3 * D, modl + 6 * 1024, modl + 7 * 1024, ng + 4 * D, H, wave, lane, rep + 1 < REP_RN, rows2 == MTOT ? D / 256 : 0);
            } else if (kind == 11) {
                const float* modn = modl + 5 * NMODW; const float* ngn = ng + 6 * D;
                rownorm_phase(a, G, rows2, false, l < 3, l == 3, Y, 0.5f, modl + 8 * 1024, ng + 5 * D, modn + 0 * 1024, modn + 1 * 1024, ngn, H, wave, lane, rep + 1 < REP_RN, rows2 == MTOT ? DFF / 256 : 0);
                if (l < 3 && rep + 1 >= REP_RN) { __syncthreads(); convert_layer(a, l + 1, lds, G, wave, lane); }
            } else if (kind == 6) {
#ifndef SKIP_AB
                ab_core_phase(a, l, lds, G, tid, wave, lane);
#endif
            } else if (kind == 12) {
#ifndef SKIP_PRE
                hy_pre_phase(a, l, lds, G, tid);
#endif
            } else if (kind == 13) {
#ifndef SKIP_CTXH
                if (l == 1 && rep == 0) hy_ctx_phase(a, l, lds, G, tid);
#endif
#ifndef SKIP_FFT
                hy_fft_phase(a, l, lds, G, tid, rep + 1 < REP_FFT);
#endif
            } else if (kind == 14) {
#ifndef SKIP_POST
                hy_post_phase(a, l, lds, G, tid);
#endif
            }
            for (int q_ = 0; q_ < REP_SYNC; ++q_) GRID_BARRIER();
        }
    }
}

#undef ws
#undef H
#undef Y
#undef Zb
#undef VT
#undef MOD
#undef NG
extern "C" void kernel_launch(void* const* d_in, const int* in_sizes, int n_in, void* d_out, int out_size, void* d_ws, size_t ws_size, hipStream_t stream) {
    static int grid = 0;
    if (grid == 0) {
        if (n_in != 26 || ws_size < WS_END) { fprintf(stderr, "kernel_launch: unexpected n_in %d or ws_size %zu (< %zu)\n", n_in, ws_size, (size_t)WS_END); grid = -1; return; }
        int dev = 0, cus = 0, per_cu = 0;
        hipGetDevice(&dev); hipDeviceGetAttribute(&cus, hipDeviceAttributeMultiprocessorCount, dev);
        hipFuncSetAttribute((const void*)fwd_megakernel, hipFuncAttributeMaxDynamicSharedMemorySize, LDS_BYTES);
        hipOccupancyMaxActiveBlocksPerMultiprocessor(&per_cu, (const void*)fwd_megakernel, NTHREADS, LDS_BYTES);
        if (per_cu < 1) { fprintf(stderr, "kernel_launch: occupancy query says %d blocks per CU\n", per_cu); per_cu = 1; }
        (void)hipGetLastError();
        grid = cus; if (grid > 256) grid = 256;
    }
    if (grid < 0) return;
    Args a{};
    for (int i = 0; i < 26; ++i) a.in[i] = (const float*)d_in[i];
    a.out = (float*)d_out; a.ws = (unsigned char*)d_ws;
    void* args[] = {&a};
    if (hipMemsetAsync((char*)d_ws + WS_BAR, 0, BAR_BYTES, stream) != hipSuccess) { fprintf(stderr, "kernel_launch: memset of barrier words failed\n"); return; }
    hipError_t e = hipLaunchCooperativeKernel((const void*)fwd_megakernel, dim3(grid), dim3(NTHREADS), args, LDS_BYTES, stream);
    if (e != hipSuccess) fprintf(stderr, "cooperative launch failed: %s (grid %d)\n", hipGetErrorString(e), grid);
}
```
